# Optimizing an MI355X kernel written in HIP

```python
import jax, jax.numpy as jnp
from jax import lax
import numpy as np

D_MODEL = 2048
BATCH = 8
SEQ = 2048
DEPTH = 2

GRID_W = 64
CTX_LEN = 256
MIX_WIDTH = D_MODEL
ATTN_WIDTH = MIX_WIDTH // 2
FOURIER_WIDTH = MIX_WIDTH - ATTN_WIDTH
HEAD_DIM = 128
N_Q_HEADS = ATTN_WIDTH // HEAD_DIM
N_KV_HEADS = max(1, N_Q_HEADS // 4)
Q_PER_KV = N_Q_HEADS // N_KV_HEADS
FOURIER_GROUP = 128
N_FOURIER_GROUPS = FOURIER_WIDTH // FOURIER_GROUP
FFN_DIM = ((8 * D_MODEL // 3 + 255) // 256) * 256
ROPE_THETA = 10000.0
Q_BLOCK = 128
EPS = 1e-6
N_MOD = 6
Q_END = N_Q_HEADS * HEAD_DIM
K_END = Q_END + N_KV_HEADS * HEAD_DIM
V_END = K_END + N_KV_HEADS * HEAD_DIM
IN_WIDTH = V_END + FOURIER_WIDTH

kernel_name = "hymba_style_attn_fnet_convglu_dit"


def rms_norm(x, g):
    xf = x.astype(jnp.float32)
    y = xf * lax.rsqrt(jnp.mean(xf * xf, axis=-1, keepdims=True) + EPS)
    return (y * g.astype(jnp.float32)).astype(x.dtype)


def modulate(x, g_pre, shift, scale):
    return rms_norm(x, g_pre) * (1 + scale) + shift


def rope_tables(n):
    rows = n // GRID_W
    row = jnp.repeat(jnp.arange(rows), GRID_W).astype(jnp.float32)
    col = jnp.tile(jnp.arange(GRID_W), rows).astype(jnp.float32)
    n_pairs_axis = HEAD_DIM // 4
    freqs = ROPE_THETA ** (-jnp.arange(n_pairs_axis, dtype=jnp.float32) / n_pairs_axis)
    ang = jnp.concatenate([row[:, None] * freqs, col[:, None] * freqs], axis=-1)
    return jnp.cos(ang), jnp.sin(ang)


def apply_rope(x, cos, sin):
    n = x.shape[1]
    bshape = (1, n) + (1,) * (x.ndim - 3) + (HEAD_DIM // 2,)
    c, s = cos.reshape(bshape), sin.reshape(bshape)
    xf = x.astype(jnp.float32).reshape(x.shape[:-1] + (HEAD_DIM // 2, 2))
    e, o = xf[..., 0], xf[..., 1]
    out = jnp.stack([e * c - o * s, e * s + o * c], axis=-1)
    return out.reshape(x.shape).astype(x.dtype)


def attend(q, k, v):
    s = jnp.einsum('bqkgd,bskd->bkgqs', q, k).astype(jnp.float32) * (HEAD_DIM ** -0.5)
    p = jax.nn.softmax(s, axis=-1).astype(v.dtype)
    return jnp.einsum('bkgqs,bskd->bqkgd', p, v)


def latent_attention(q, k_lat, v_lat, k_ctx, v_ctx):
    b, n = q.shape[:2]
    k_all = jnp.concatenate([k_lat, k_ctx], axis=1)
    v_all = jnp.concatenate([v_lat, v_ctx], axis=1)
    nb = n // Q_BLOCK
    qb = jnp.moveaxis(q.reshape((b, nb, Q_BLOCK) + q.shape[2:]), 1, 0)
    out = lax.map(lambda blk: attend(blk, k_all, v_all), qb)
    return jnp.moveaxis(out, 0, 1).reshape(b, n, ATTN_WIDTH)


def split_proj(p):
    b, t = p.shape[:2]
    q = p[..., :Q_END].reshape(b, t, N_KV_HEADS, Q_PER_KV, HEAD_DIM)
    k = p[..., Q_END:K_END].reshape(b, t, N_KV_HEADS, HEAD_DIM)
    v = p[..., K_END:V_END].reshape(b, t, N_KV_HEADS, HEAD_DIM)
    f = p[..., V_END:]
    return q, k, v, f


def fourier_mix(u, w_four):
    b, t = u.shape[:2]
    g = u.reshape(b, t, N_FOURIER_GROUPS, FOURIER_GROUP).astype(jnp.float32)
    f = jnp.fft.fft2(g, axes=(1, 3), norm='ortho').real.astype(u.dtype)
    return jnp.einsum('btgc,gcd->btgd', f, w_four).reshape(b, t, FOURIER_WIDTH)


def merge_groups(attn_out, four_out, g_attn, g_four, w_out):
    y = jnp.concatenate([rms_norm(attn_out, g_attn), rms_norm(four_out, g_four)], axis=-1)
    return y @ w_out


def dwconv3(u, w, b):
    up = jnp.pad(u, ((0, 0), (1, 1), (0, 0)))
    return up[:, :-2] * w[0] + up[:, 1:-1] * w[1] + up[:, 2:] * w[2] + b


def conv_glu(h, w_up, conv_w, conv_b, w_down):
    u = h @ w_up
    gate, val = u[..., :FFN_DIM], u[..., FFN_DIM:]
    return (jax.nn.gelu(dwconv3(gate, conv_w, conv_b)) * val) @ w_down


def setup_inputs(seed: int = 0) -> dict:
    key = jax.random.key(seed)
    ks = jax.random.split(key, 21)
    f32 = jnp.float32

    def nrm(k, shape, s):
        return s * jax.random.normal(k, shape, f32)

    def gain(k, shape):
        return 1.0 + 0.1 * jax.random.normal(k, shape, f32)

    return {
        "x": nrm(ks[0], (BATCH, SEQ, D_MODEL), 1.0),
        "c": nrm(ks[1], (BATCH, D_MODEL), 1.0),
        "ctx": nrm(ks[2], (BATCH, CTX_LEN, D_MODEL), 1.0),
        "c_ctx": nrm(ks[3], (D_MODEL,), 1.0),
        "w_mod": nrm(ks[4], (DEPTH, D_MODEL, N_MOD * D_MODEL), 0.5 * D_MODEL ** -0.5),
        "b_mod": nrm(ks[5], (DEPTH, N_MOD * D_MODEL), 0.02),
        "g_pre_mix": gain(ks[6], (DEPTH, D_MODEL)),
        "g_post_mix": gain(ks[7], (DEPTH, D_MODEL)),
        "g_pre_ffn": gain(ks[8], (DEPTH, D_MODEL)),
        "g_post_ffn": gain(ks[9], (DEPTH, D_MODEL)),
        "w_in": nrm(ks[10], (DEPTH, D_MODEL, IN_WIDTH), D_MODEL ** -0.5),
        "q_norm": gain(ks[11], (DEPTH, HEAD_DIM)),
        "k_norm": gain(ks[12], (DEPTH, HEAD_DIM)),
        "w_four": nrm(ks[13], (DEPTH, N_FOURIER_GROUPS, FOURIER_GROUP, FOURIER_GROUP), FOURIER_GROUP ** -0.5),
        "g_attn_out": gain(ks[14], (DEPTH, ATTN_WIDTH)),
        "g_four_out": gain(ks[15], (DEPTH, FOURIER_WIDTH)),
        "w_out": nrm(ks[16], (DEPTH, MIX_WIDTH, D_MODEL), MIX_WIDTH ** -0.5),
        "w_up": nrm(ks[17], (DEPTH, D_MODEL, 2 * FFN_DIM), D_MODEL ** -0.5),
        "conv_w": nrm(ks[18], (DEPTH, 3, FFN_DIM), 3 ** -0.5),
        "conv_b": nrm(ks[19], (DEPTH, FFN_DIM), 0.02),
        "w_down": nrm(ks[20], (DEPTH, FFN_DIM, D_MODEL), FFN_DIM ** -0.5),
    }


def reference(x, c, ctx, c_ctx, w_mod, b_mod, g_pre_mix, g_post_mix, g_pre_ffn, g_post_ffn,
              w_in, q_norm, k_norm, w_four, g_attn_out, g_four_out, w_out,
              w_up, conv_w, conv_b, w_down):
    b, n, d = x.shape
    ROWS = n // GRID_W
    cos, sin = rope_tables(ROWS * GRID_W)
    xc = ctx
    silu_c = jax.nn.silu(c)
    silu_cc = jax.nn.silu(c_ctx)

    for i in range(DEPTH):
        last = i == DEPTH - 1
        mod_l = (silu_c @ w_mod[i] + b_mod[i]).reshape(b, N_MOD, 1, d)
        mod_c = (silu_cc @ w_mod[i] + b_mod[i]).reshape(N_MOD, d)

        h_l = modulate(x, g_pre_mix[i], mod_l[:, 0], mod_l[:, 1])
        h_c = modulate(xc, g_pre_mix[i], mod_c[0], mod_c[1])

        q_l, k_l, v_l, f_l = split_proj(h_l @ w_in[i])
        q_l = apply_rope(rms_norm(q_l, q_norm[i]), cos, sin)
        k_l = apply_rope(rms_norm(k_l, k_norm[i]), cos, sin)

        if last:
            p_kv = h_c @ w_in[i][:, Q_END:V_END]
            k_c = rms_norm(p_kv[..., :K_END - Q_END].reshape(b, -1, N_KV_HEADS, HEAD_DIM), k_norm[i])
            v_c = p_kv[..., K_END - Q_END:].reshape(b, -1, N_KV_HEADS, HEAD_DIM)
        else:
            q_c, k_c, v_c, f_c = split_proj(h_c @ w_in[i])
            q_c = rms_norm(q_c, q_norm[i])
            k_c = rms_norm(k_c, k_norm[i])

        attn_l = latent_attention(q_l, k_l, v_l, k_c, v_c)
        four_l = fourier_mix(f_l, w_four[i])
        mix_l = merge_groups(attn_l, four_l, g_attn_out[i], g_four_out[i], w_out[i])
        x_new = x + mod_l[:, 2] * rms_norm(mix_l, g_post_mix[i])

        if not last:
            attn_c = attend(q_c, k_c, v_c).reshape(b, -1, ATTN_WIDTH)
            four_c = fourier_mix(f_c, w_four[i])
            mix_c = merge_groups(attn_c, four_c, g_attn_out[i], g_four_out[i], w_out[i])
            xc = xc + mod_c[2] * rms_norm(mix_c, g_post_mix[i])
        x = x_new

        h_l = modulate(x, g_pre_ffn[i], mod_l[:, 3], mod_l[:, 4])
        y_l = conv_glu(h_l, w_up[i], conv_w[i], conv_b[i], w_down[i])
        x = x + mod_l[:, 5] * rms_norm(y_l, g_post_ffn[i])
        if not last:
            h_c = modulate(xc, g_pre_ffn[i], mod_c[3], mod_c[4])
            y_c = conv_glu(h_c, w_up[i], conv_w[i], conv_b[i], w_down[i])
            xc = xc + mod_c[5] * rms_norm(y_c, g_post_ffn[i])

    return x
```

```cpp
#include <hip/hip_runtime.h>
#include <hip/hip_bf16.h>
#include <hip/hip_cooperative_groups.h>
#include <cstdio>
#include <cstdint>
namespace cg = cooperative_groups;

constexpr int DM = 2048, NB = 8, SEQ = 2048, CTXL = 256, DEPTH = 2;
constexpr int ML = NB * SEQ, MC = NB * CTXL, MT = ML + MC;
constexpr int INW = 2560, QKVW = 1536, FFN = 5632, UPW = 2 * FFN, NMODC = 6 * DM;
constexpr int SKV = SEQ + CTXL;
constexpr float EPS = 1e-6f;
constexpr int NTHREADS = 512, NWAVES = 8;

#define LAS __attribute__((address_space(3)))
typedef unsigned short bf16_t;
typedef short bf16x8 __attribute__((ext_vector_type(8)));
typedef float f32x4 __attribute__((ext_vector_type(4)));
typedef float f32x2 __attribute__((ext_vector_type(2)));
typedef unsigned u32x4 __attribute__((ext_vector_type(4)));
typedef unsigned u32x2 __attribute__((ext_vector_type(2)));
using f32x16 = __attribute__((ext_vector_type(16))) float;
using s16x4 = __attribute__((ext_vector_type(4))) short;

constexpr size_t MiB = 1u << 20;
constexpr size_t WS_MOD = 1 * MiB;
constexpr size_t WS_MODP = 2 * MiB;
constexpr size_t WS_CWS = 16 * MiB;
constexpr size_t WS_D256 = 17 * MiB;
constexpr size_t WS_D2048 = 18 * MiB;
constexpr size_t WS_WIN = 34 * MiB;
constexpr size_t WS_WOUT = 54 * MiB;
constexpr size_t WS_WUP = 70 * MiB;
constexpr size_t WS_WDN = 158 * MiB;
constexpr size_t WS_XC = 202 * MiB;
constexpr size_t WS_H = 218 * MiB;
constexpr size_t WS_MIX = 290 * MiB;
constexpr size_t WS_R1 = 362 * MiB;
constexpr size_t WS_P = WS_R1;
constexpr size_t WS_QN = WS_R1 + 90 * MiB;
constexpr size_t WS_KALL = WS_R1 + 126 * MiB;
constexpr size_t WS_VALL = WS_R1 + 135 * MiB;
constexpr size_t WS_YTL = WS_R1 + 144 * MiB;
constexpr size_t WS_YTC = WS_R1 + 208 * MiB;
constexpr size_t WS_ATTO = WS_R1 + 216 * MiB;
constexpr size_t WS_FOURO = WS_R1 + 252 * MiB;
constexpr size_t WS_ZP = WS_R1 + 200 * MiB;
constexpr size_t WS_GV = WS_R1 + 207 * MiB;
constexpr size_t WS_VV = WS_R1 + 214 * MiB;
constexpr size_t WS_NYQ = 1 * MiB + 960 * 1024;
constexpr size_t WS_YPART = WS_R1 + 288 * MiB;
constexpr size_t WS_XS = WS_R1 + 320 * MiB;
constexpr size_t WS_END = WS_R1 + 396 * MiB;
constexpr int CWL_OFF = 131072 + 1024;
constexpr int QKP_OFF = CWL_OFF + 4096;
constexpr int LDS_BYTES = 131072 + 1024 + 4096 + 8192;

struct Params { const float* in[21]; float* out; unsigned char* ws; };
typedef const __attribute__((address_space(4))) Params* KP;

__device__ __forceinline__ unsigned cvt_pk_bf16(float lo, float hi) { unsigned r; asm volatile("v_cvt_pk_bf16_f32 %0, %1, %2" : "=v"(r) : "v"(lo), "v"(hi)); return r; }
__device__ __forceinline__ float bf_lo(unsigned w) { return __uint_as_float(w << 16); }
__device__ __forceinline__ float bf_hi(unsigned w) { return __uint_as_float(w & 0xffff0000u); }
__device__ __forceinline__ float wave_sum(float v) {
#pragma unroll
    for (int o = 1; o < 64; o <<= 1) v += __shfl_xor(v, o);
    return v;
}
__device__ __forceinline__ float gelu_tanh(float z) {
    const float t = z * (0.044715f * z * z + 1.f);
    const float e = __builtin_amdgcn_exp2f(t * (-2.f * 0.7978845608028654f * 1.4426950408889634f));
    return z * __builtin_amdgcn_rcpf(1.f + e);
}

namespace pg8 {
constexpr int BM = 256, BK = 64, HALF = 128, HTB = HALF * BK * 2, STAGE_BYTES = 8 * HTB, NXCD = 8, WGM = 8;
__device__ __forceinline__ int lds_byte(int r, int c) { const int st = (r >> 4) * 2 + (c >> 5), rr = r & 15, cc = c & 31, ob = rr * 64 + cc * 2; return st * 1024 + (ob ^ (((ob >> 9) & 1) << 5)); }
__device__ __forceinline__ void stage_rc(int b, int& R, int& C) { const int st = b / 1024, sb = b % 1024, swz = sb ^ (((sb >> 9) & 1) << 5); R = (st >> 1) * 16 + swz / 64; C = (st & 1) * 32 + (swz % 64) / 2; }
__device__ __forceinline__ int perm32(int rho) { const int n = rho >> 4, i = rho & 15; return 8 * (i >> 2) + 4 * n + (i & 3); }

struct Unit { int pm, pn, ks; };
struct Job {
    const bf16_t* A; const bf16_t* B; bf16_t* O;
    int lda, ldb, ldc, K, nM, nN;
    int ksplit; long ostride_ks;
    int amod, bdiv; long astride, bstride_m, bstride_n;
    int mode; float scale; bf16_t* O2;
    const float* cw; const float* cb; float* zp; float* gv; float* vv;
    bf16_t* qn; bf16_t* kall; bf16_t* vall;
    __device__ __forceinline__ const char* aptr(const Unit& u) const { return (const char*)(A + (size_t)(u.pm % amod) * astride + (size_t)u.ks * K); }
    __device__ __forceinline__ const char* bptr(const Unit& u) const { return (const char*)(B + (size_t)(u.pm / bdiv) * bstride_m + (size_t)u.pn * bstride_n + (size_t)u.ks * K); }
};
struct StaticOrder {
    int nM, nN, nwg, G, c;
    __device__ void init(int nM_, int nN_, int G_, int c_) { nM = nM_; nN = nN_; nwg = nM * nN; G = G_; c = c_; }
    __device__ bool next(int i, Unit& u) const {
        const long L = (long)i * G + c; if (L >= nwg) return false;
        int wgid = (int)L; { const int q = nwg / NXCD, r = nwg % NXCD, xcd = wgid % NXCD, off = wgid / NXCD; wgid = (xcd < r ? xcd * (q + 1) : r * (q + 1) + (xcd - r) * q) + off; }
        const int nig = WGM * nN, gid = wgid / nig, fm = gid * WGM, gsz = (nM - fm) < WGM ? (nM - fm) : WGM;
        u.pm = fm + ((wgid % nig) % gsz); u.pn = (wgid % nig) / gsz; u.ks = 0; return true;
    }
};

__device__ __forceinline__ void epilogue(const Job& J, const f32x4 (&acc)[2][2][4][2], const Unit& u, int wr, int wc, int fr, int fq, LAS unsigned char* lds, int upar) {
    asm volatile("" : "+v"(fr), "+v"(fq));
    const float sc = J.scale;
    if (J.mode == 0 || (J.mode == 3 && u.pn >= 6)) {
        const int row0 = u.pm * BM + wr * 64 + fr, col0 = u.pn * BM + wc * 32 + 8 * fq;
#pragma unroll
        for (int ai = 0; ai < 2; ++ai)
#pragma unroll
            for (int m = 0; m < 4; ++m) { bf16_t* rowp = J.O + (size_t)u.ks * J.ostride_ks + (size_t)(row0 + ai * HALF + m * 16) * J.ldc + col0;
#pragma unroll
                for (int bj = 0; bj < 2; ++bj) { const f32x4 v0 = acc[ai][bj][m][0] * sc, v1 = acc[ai][bj][m][1] * sc;
                    u32x4 w; w.x = cvt_pk_bf16(v0[0], v0[1]); w.y = cvt_pk_bf16(v0[2], v0[3]); w.z = cvt_pk_bf16(v1[0], v1[1]); w.w = cvt_pk_bf16(v1[2], v1[3]);
                    *(u32x4*)(rowp + bj * HALF) = w; } }
    } else if (J.mode == 3) {
        const bool lat = u.pm < 64, nrm = u.pn < 5;
        const int rl0 = wr * 64 + fr, cl = wc * 32 + 8 * fq;
        if (nrm) {
            LAS float* part = (LAS float*)(lds + QKP_OFF);
#pragma unroll
            for (int ai = 0; ai < 2; ++ai)
#pragma unroll
                for (int m = 0; m < 4; ++m)
#pragma unroll
                    for (int bj = 0; bj < 2; ++bj) { const f32x4 a = acc[ai][bj][m][0], b = acc[ai][bj][m][1];
                        float sq = (a[0] * a[0] + a[1] * a[1]) + (a[2] * a[2] + a[3] * a[3]) + (b[0] * b[0] + b[1] * b[1]) + (b[2] * b[2] + b[3] * b[3]);
                        sq += __shfl_xor(sq, 16); sq += __shfl_xor(sq, 32);
                        if (fq == 0) part[(rl0 + 128 * ai + 16 * m) * 8 + bj * 4 + wc] = sq; }
            asm volatile("s_waitcnt lgkmcnt(0)" ::: "memory"); __builtin_amdgcn_s_barrier(); asm volatile("" ::: "memory");
        }
        const LAS float* nw = (const LAS float*)(lds + CWL_OFF) + (u.pn == 4 ? 128 : 0) + cl;
        float gw[8];
        { const f32x4 a = *(const LAS f32x4*)nw, b = *(const LAS f32x4*)(nw + 4); gw[0] = a[0]; gw[1] = a[1]; gw[2] = a[2]; gw[3] = a[3]; gw[4] = b[0]; gw[5] = b[1]; gw[6] = b[2]; gw[7] = b[3]; }
        float frq[4];
#pragma unroll
        for (int i = 0; i < 4; ++i) frq[i] = __builtin_amdgcn_exp2f(-(float)((16 * wc + 4 * fq + i) & 31) * (13.287712379549449f / 32.f));
#pragma unroll
        for (int ai = 0; ai < 2; ++ai)
#pragma unroll
            for (int m = 0; m < 4; ++m) {
                const int rl = rl0 + 128 * ai + 16 * m, t = ((u.pm & 7) << 8) + rl;
                float cs[4], sn[4];
#pragma unroll
                for (int i = 0; i < 4; ++i) { cs[i] = 1.f; sn[i] = 0.f; }
                if (lat && nrm) { const float pos = (float)(wc < 2 ? (t >> 6) : (t & 63));
#pragma unroll
                    for (int i = 0; i < 4; ++i) { float rev = pos * frq[i] * 0.15915494309189535f; rev -= floorf(rev); cs[i] = __builtin_amdgcn_cosf(rev); sn[i] = __builtin_amdgcn_sinf(rev); } }
                const size_t row = (size_t)u.pm * BM + rl;
                const size_t kvrow = lat ? (size_t)(u.pm >> 3) * SKV + t : (size_t)(u.pm - 64) * SKV + SEQ + rl;
#pragma unroll
                for (int bj = 0; bj < 2; ++bj) {
                    float v[8];
#pragma unroll
                    for (int e = 0; e < 8; ++e) v[e] = acc[ai][bj][m][e >> 2][e & 3];
                    if (nrm) { const f32x4 p4 = *(const LAS f32x4*)((const LAS float*)(lds + QKP_OFF) + rl * 8 + bj * 4);
                        const float rs = __builtin_amdgcn_rsqf(((p4[0] + p4[1]) + (p4[2] + p4[3])) * (1.f / 128.f) + EPS);
#pragma unroll
                        for (int i = 0; i < 4; ++i) { const float e0 = v[2 * i] * rs * gw[2 * i], o0 = v[2 * i + 1] * rs * gw[2 * i + 1];
                            v[2 * i] = e0 * cs[i] - o0 * sn[i]; v[2 * i + 1] = e0 * sn[i] + o0 * cs[i]; } }
                    u32x4 w; w.x = cvt_pk_bf16(v[0], v[1]); w.y = cvt_pk_bf16(v[2], v[3]); w.z = cvt_pk_bf16(v[4], v[5]); w.w = cvt_pk_bf16(v[6], v[7]);
                    bf16_t* dst = u.pn < 4 ? J.qn + row * 1024 + (2 * u.pn + bj) * 128 + cl : (u.pn == 4 ? J.kall : J.vall) + kvrow * 256 + bj * 128 + cl;
                    *(u32x4*)dst = w;
                }
                __builtin_amdgcn_sched_barrier(0);
            }
    } else if (J.mode == 2) {
        const int colg = u.pn * 128 + wc * 32 + 8 * fq, rowb = u.pm * BM + wr * 128 + fr * 8;
        const LAS float* cwl = (const LAS float*)(lds + CWL_OFF + upar * 2048) + wc * 32 + 8 * fq;
        f32x2 w0[4], w1[4], w2[4], bb[4];
#pragma unroll
        for (int h = 0; h < 2; ++h) { const f32x4 a = *(const LAS f32x4*)(cwl + 4 * h), b = *(const LAS f32x4*)(cwl + 128 + 4 * h), c = *(const LAS f32x4*)(cwl + 256 + 4 * h), d = *(const LAS f32x4*)(cwl + 384 + 4 * h);
            w0[2 * h] = (f32x2){a[0], a[1]}; w0[2 * h + 1] = (f32x2){a[2], a[3]}; w1[2 * h] = (f32x2){b[0], b[1]}; w1[2 * h + 1] = (f32x2){b[2], b[3]};
            w2[2 * h] = (f32x2){c[0], c[1]}; w2[2 * h + 1] = (f32x2){c[2], c[3]}; bb[2 * h] = (f32x2){d[0], d[1]}; bb[2 * h + 1] = (f32x2){d[2], d[3]}; }
#define GP2(j, q) ((f32x2){acc[(j) >> 2][0][(j) & 3][(q) >> 1][((q) & 1) * 2], acc[(j) >> 2][0][(j) & 3][(q) >> 1][((q) & 1) * 2 + 1]})
#define VP2(j, q) ((f32x2){acc[(j) >> 2][1][(j) & 3][(q) >> 1][((q) & 1) * 2], acc[(j) >> 2][1][(j) & 3][(q) >> 1][((q) & 1) * 2 + 1]})
        f32x2 gprev[4], gnext[4];
#pragma unroll
        for (int q = 0; q < 4; ++q) {
            const f32x2 last = GP2(7, q), first = GP2(0, q);
            gprev[q].x = __uint_as_float((unsigned)__builtin_amdgcn_update_dpp(0, (int)__float_as_uint(last.x), 0x111, 0xf, 0xf, false));
            gprev[q].y = __uint_as_float((unsigned)__builtin_amdgcn_update_dpp(0, (int)__float_as_uint(last.y), 0x111, 0xf, 0xf, false));
            gnext[q].x = __uint_as_float((unsigned)__builtin_amdgcn_update_dpp(0, (int)__float_as_uint(first.x), 0x101, 0xf, 0xf, false));
            gnext[q].y = __uint_as_float((unsigned)__builtin_amdgcn_update_dpp(0, (int)__float_as_uint(first.y), 0x101, 0xf, 0xf, false));
        }
        bf16_t* orow = J.O + (size_t)rowb * FFN + colg;
#pragma unroll
        for (int j = 0; j < 8; ++j) {
            f32x2 z[4]; unsigned ow[4];
#pragma unroll
            for (int q = 0; q < 4; ++q) {
                const f32x2 gp = j == 0 ? gprev[q] : GP2(j == 0 ? 0 : j - 1, q);
                const f32x2 gn = j == 7 ? gnext[q] : GP2(j == 7 ? 7 : j + 1, q);
                z[q] = gp * w0[q] + (GP2(j, q) * w1[q] + (gn * w2[q] + bb[q]));
                const f32x2 zz = z[q], t = zz * (zz * zz * 0.044715f + 1.0f), ex = t * (-2.302208198f);
                f32x2 d; d.x = __builtin_amdgcn_exp2f(ex.x); d.y = __builtin_amdgcn_exp2f(ex.y); d = d + 1.0f;
                f32x2 r; r.x = __builtin_amdgcn_rcpf(d.x); r.y = __builtin_amdgcn_rcpf(d.y);
                const f32x2 a = zz * r * VP2(j, q);
                ow[q] = cvt_pk_bf16(a.x, a.y);
            }
            u32x4 w; w.x = ow[0]; w.y = ow[1]; w.z = ow[2]; w.w = ow[3];
            *(u32x4*)(orow + (size_t)j * FFN) = w;
            if ((j == 0 && fr == 0) || (j == 7 && fr == 15)) {
                const size_t sb = (size_t)(u.pm * 4 + wr * 2 + (j == 7 ? 1 : 0)) * FFN + colg;
                *(f32x4*)(J.zp + sb) = (f32x4){z[0].x, z[0].y, z[1].x, z[1].y}; *(f32x4*)(J.zp + sb + 4) = (f32x4){z[2].x, z[2].y, z[3].x, z[3].y};
                *(f32x4*)(J.gv + sb) = acc[j >> 2][0][j & 3][0]; *(f32x4*)(J.gv + sb + 4) = acc[j >> 2][0][j & 3][1];
                *(f32x4*)(J.vv + sb) = acc[j >> 2][1][j & 3][0]; *(f32x4*)(J.vv + sb + 4) = acc[j >> 2][1][j & 3][1];
            }
        }
#undef GP2
#undef VP2
    } else {
        const bool lat = u.pn < 64;
        const int b = lat ? (u.pn >> 3) : (u.pn - 64), tbase = lat ? (u.pn & 7) * 256 : 0;
        const int ldy = lat ? SEQ : 2 * CTXL; const size_t halfoff = lat ? (size_t)1024 * SEQ : (size_t)CTXL;
        bf16_t* base = (lat ? J.O + (size_t)(b * 2048 + u.pm * 128) * ldy : J.O2 + (size_t)(b * 1024 + u.pm * 128) * ldy) + tbase + wc * 32 + 8 * fq;
#pragma unroll
        for (int ai = 0; ai < 2; ++ai)
#pragma unroll
            for (int m = 0; m < 4; ++m) { bf16_t* rowp = base + (size_t)(wr * 64 + m * 16 + fr) * ldy + ai * halfoff;
#pragma unroll
                for (int bj = 0; bj < 2; ++bj) { const f32x4 v0 = acc[ai][bj][m][0] * sc, v1 = acc[ai][bj][m][1] * sc;
                    u32x4 w; w.x = cvt_pk_bf16(v0[0], v0[1]); w.y = cvt_pk_bf16(v0[2], v0[3]); w.z = cvt_pk_bf16(v1[0], v1[1]); w.w = cvt_pk_bf16(v1[2], v1[3]);
                    *(u32x4*)(rowp + bj * HALF) = w; } }
    }
}

__device__ __forceinline__ void gemm_phase(LAS unsigned char* lds, const Job& g, const StaticOrder& S, const int tid) {
    const int wid = __builtin_amdgcn_readfirstlane(tid >> 6), lane = tid & 63, wr = wid >> 2, wc = wid & 3, fr = lane & 15, fq = lane >> 4;
    const int K = g.K, nt = K / BK;
    unsigned voffA[2], voffB[2];
#pragma unroll
    for (int i = 0; i < 2; ++i) { int R, C; stage_rc(tid * 16 + i * 8192, R, C); const int Rb = (R & ~31) + perm32(R & 31);
        const int Ra = g.mode == 2 ? ((R >> 6) * 128 + (R & 15) * 8 + ((R >> 4) & 3)) : R;
        voffA[i] = (unsigned)(Ra * g.lda + C) * 2u; voffB[i] = (unsigned)(Rb * g.ldb + C) * 2u; }
    const size_t kstep = (size_t)(BK * 2);
    const size_t hstepA = (size_t)(g.mode == 2 ? 4 : HALF) * g.lda * 2, hstepB = (size_t)HALF * g.ldb * 2;
    const unsigned ldsw = (unsigned)wid * 1024u;
    const int aoff = lds_byte(wr * 64 + fr, fq * 8), boff = lds_byte(wc * 32 + fr, fq * 8);
#define PG8_SA(b, h) (((b) * 2 + (h)) * HTB)
#define PG8_SB(b, h) ((4 + (b) * 2 + (h)) * HTB)
#define PG8_STAGE(bufoff, gbase, voff) do { _Pragma("unroll") for (int _i = 0; _i < 2; ++_i) \
        __builtin_amdgcn_global_load_lds((const unsigned*)((const char*)(gbase) + (voff)[_i]), (LAS unsigned*)(lds + (bufoff) + ldsw + _i * 8192), 16, 0, 0); } while (0)
#define PG8_LDA(dst, b, h) do { _Pragma("unroll") for (int m = 0; m < 4; ++m) _Pragma("unroll") for (int k = 0; k < 2; ++k) dst[m][k] = *(const LAS bf16x8*)(lds + PG8_SA(b, h) + aoff + m * 2048 + k * 1024); } while (0)
#define PG8_LDB(dst, b, h) do { _Pragma("unroll") for (int n = 0; n < 2; ++n) _Pragma("unroll") for (int k = 0; k < 2; ++k) dst[n][k] = *(const LAS bf16x8*)(lds + PG8_SB(b, h) + boff + n * 2048 + k * 1024); } while (0)
#define PG8_MMA(ai, bj, At, Bt) do { __builtin_amdgcn_s_setprio(1); _Pragma("unroll") for (int m = 0; m < 4; ++m) _Pragma("unroll") for (int n = 0; n < 2; ++n) _Pragma("unroll") for (int k = 0; k < 2; ++k) \
        acc[ai][bj][m][n] = __builtin_amdgcn_mfma_f32_16x16x32_bf16(Bt[n][k], At[m][k], acc[ai][bj][m][n], 0, 0, 0); __builtin_amdgcn_s_setprio(0); } while (0)
#define PG8_WAIT_V(n) asm volatile("s_waitcnt vmcnt(" #n ")" ::: "memory")
#define PG8_WAIT_L(n) asm volatile("s_waitcnt lgkmcnt(" #n ")" ::: "memory")
#define PG8_BAR __builtin_amdgcn_s_barrier()
#define PG8_SCHED __builtin_amdgcn_sched_barrier(0)
    Unit cur, nxt; int ui = 0;
#define PG8_FIXKS(u) do { if (g.ksplit > 1) { (u).ks = (u).pn / g.nN; (u).pn -= (u).ks * g.nN; } } while (0)
    if (!S.next(0, cur)) return;
    PG8_FIXKS(cur);
    f32x4 acc[2][2][4][2];
#pragma unroll
    for (int a = 0; a < 2; ++a)
#pragma unroll
        for (int b = 0; b < 2; ++b)
#pragma unroll
            for (int m = 0; m < 4; ++m)
#pragma unroll
                for (int n = 0; n < 2; ++n) acc[a][b][m][n] = (f32x4){0.f, 0.f, 0.f, 0.f};
    bf16x8 At[4][2], B0[2][2], B1[2][2];
    const char* cA = g.aptr(cur); const char* cB = g.bptr(cur);
    PG8_STAGE(PG8_SB(0, 0), cB, voffB); PG8_STAGE(PG8_SB(0, 1), cB + hstepB, voffB); PG8_STAGE(PG8_SA(0, 0), cA, voffA); PG8_STAGE(PG8_SA(0, 1), cA + hstepA, voffA);
    if (wr == 1) PG8_BAR;
    PG8_WAIT_V(2); PG8_BAR;
    PG8_STAGE(PG8_SB(1, 0), cB + kstep, voffB); PG8_STAGE(PG8_SA(1, 0), cA + kstep, voffA); PG8_STAGE(PG8_SB(1, 1), cB + hstepB + kstep, voffB);
    PG8_WAIT_V(6); PG8_BAR;
    for (;;) {
        const bool has_next = S.next(ui + 1, nxt);
        if (has_next) PG8_FIXKS(nxt);
        if (g.mode == 2) {
            const int arr = wid >> 1;
            const float* src = (arr < 3 ? g.cw + arr * FFN : g.cb) + cur.pn * 128 + (wid & 1) * 64 + lane;
            __builtin_amdgcn_global_load_lds((const unsigned*)src, (LAS unsigned*)(lds + CWL_OFF + (ui & 1) * 2048 + wid * 256), 4, 0, 0);
        }
        const char* nA = has_next ? g.aptr(nxt) : cA; const char* nB = has_next ? g.bptr(nxt) : cB;
        for (int t = 0; t < nt; t += 2) {
            const bool last = (t == nt - 2);
            const char* a1 = cA + (size_t)(t + 1) * kstep;
            const char* a2 = last ? nA : cA + (size_t)(t + 2) * kstep; const char* b2 = last ? nB : cB + (size_t)(t + 2) * kstep;
            const char* a3 = a2 + kstep; const char* b3 = b2 + kstep;
            PG8_LDB(B0, 0, 0); PG8_LDB(B1, 0, 1); PG8_SCHED; PG8_LDA(At, 0, 0); PG8_STAGE(PG8_SA(1, 1), a1 + hstepA, voffA);
            PG8_WAIT_V(8); PG8_WAIT_L(0); PG8_BAR; PG8_MMA(0, 0, At, B0); PG8_MMA(0, 1, At, B1); PG8_BAR; PG8_SCHED;
            PG8_LDA(At, 0, 1); PG8_STAGE(PG8_SB(0, 0), b2, voffB); PG8_STAGE(PG8_SB(0, 1), b2 + hstepB, voffB); PG8_STAGE(PG8_SA(0, 0), a2, voffA);
            PG8_WAIT_V(8); PG8_WAIT_L(0); PG8_BAR; PG8_MMA(1, 0, At, B0); PG8_MMA(1, 1, At, B1); PG8_BAR; PG8_SCHED;
            PG8_LDB(B0, 1, 0); PG8_LDB(B1, 1, 1); PG8_SCHED; PG8_LDA(At, 1, 0); PG8_STAGE(PG8_SA(0, 1), a2 + hstepA, voffA);
            PG8_WAIT_V(8); PG8_WAIT_L(0); PG8_BAR; PG8_MMA(0, 0, At, B0); PG8_MMA(0, 1, At, B1); PG8_BAR; PG8_SCHED;
            PG8_LDA(At, 1, 1); PG8_STAGE(PG8_SB(1, 0), b3, voffB); PG8_STAGE(PG8_SB(1, 1), b3 + hstepB, voffB); PG8_STAGE(PG8_SA(1, 0), a3, voffA);
            PG8_WAIT_V(8); PG8_WAIT_L(0); PG8_BAR; PG8_MMA(1, 0, At, B0); PG8_MMA(1, 1, At, B1); PG8_BAR; PG8_SCHED;
        }
        if (wr == 0) PG8_BAR;
        epilogue(g, acc, cur, wr, wc, fr, fq, lds, ui & 1);
        if (!has_next) break;
#pragma unroll
        for (int a = 0; a < 2; ++a)
#pragma unroll
            for (int b = 0; b < 2; ++b)
#pragma unroll
                for (int m = 0; m < 4; ++m)
#pragma unroll
                    for (int n = 0; n < 2; ++n) acc[a][b][m][n] = (f32x4){0.f, 0.f, 0.f, 0.f};
        cur = nxt; cA = nA; cB = nB; ++ui;
        if (wr == 1) PG8_BAR;
    }
    PG8_WAIT_V(0);
    PG8_BAR;
#undef PG8_FIXKS
#undef PG8_SA
#undef PG8_SB
#undef PG8_STAGE
#undef PG8_LDA
#undef PG8_LDB
#undef PG8_MMA
#undef PG8_WAIT_V
#undef PG8_WAIT_L
#undef PG8_BAR
#undef PG8_SCHED
}
}

namespace att {
using bf16 = __hip_bfloat16;
constexpr int D = 128, NW = 8, QBLK = 32, KVBLK = 64;
constexpr float SCALE = 0.088388347648318440f;
constexpr float THR = 8.f;
#ifndef ATT_SDEPTH
#define ATT_SDEPTH 2
#endif
constexpr int LDQ = 1024, LDK = 256, LDO = 1024;
constexpr size_t SHM_V = KVBLK * D * 2, SHM_K = KVBLK * D * 2, SHM_ATTN = 2 * SHM_V + 2 * SHM_K + NW * 64 * 4;
#define KSWZ(row, colB) ((row) * 256 + ((colB) ^ (((row) & 7) << 4)))
#define SBAR() __builtin_amdgcn_sched_barrier(0)
__device__ __forceinline__ int crow(int r, int hi) { return (r & 3) + 8 * (r >> 2) + 4 * hi; }
__device__ __forceinline__ unsigned cvtpk(float lo, float hi) { unsigned r; asm volatile("v_cvt_pk_bf16_f32 %0, %1, %2" : "=v"(r) : "v"(lo), "v"(hi)); return r; }
__device__ __forceinline__ bf16x8 ld8(const bf16* p) { return *reinterpret_cast<const bf16x8*>(p); }
__device__ __forceinline__ void partialSM(f32x16& p0, f32x16& p1, float& m_reg, float& mn, float& alpha) {
  constexpr float C = SCALE * 1.4426950408889634f;
  float pmax = p0[0]; for (int r = 1; r < 16; ++r) pmax = fmaxf(pmax, p0[r]); for (int r = 0; r < 16; ++r) pmax = fmaxf(pmax, p1[r]);
  { auto rr = __builtin_amdgcn_permlane32_swap(__float_as_uint(pmax), __float_as_uint(pmax), false, false);
    pmax = fmaxf(__uint_as_float(rr[0]), __uint_as_float(rr[1])); }
  if (__builtin_expect(__all(pmax - m_reg <= THR / SCALE), 1)) { mn = m_reg; alpha = 1.f; }
  else { mn = fmaxf(m_reg, pmax); alpha = __builtin_amdgcn_exp2f((m_reg - mn) * C); m_reg = mn; }
  float mnC = -mn * C;
  for (int r = 0; r < 16; ++r) p0[r] = fmaf(p0[r], C, mnC); for (int r = 0; r < 16; ++r) p1[r] = fmaf(p1[r], C, mnC);
  for (int r = 0; r < 16; ++r) p0[r] = __builtin_amdgcn_exp2f(p0[r]);
}
__device__ __forceinline__ void finishSM(f32x16& p0, f32x16& p1, float alpha, float& l_reg, bf16x8& pa0, bf16x8& pa1, bf16x8& pa2, bf16x8& pa3) {
  for (int r = 0; r < 16; ++r) p1[r] = __builtin_amdgcn_exp2f(p1[r]);
  float ps = 0; for (int r = 0; r < 16; ++r) ps += p0[r]; for (int r = 0; r < 16; ++r) ps += p1[r];
  { auto rr = __builtin_amdgcn_permlane32_swap(__float_as_uint(ps), __float_as_uint(ps), false, false);
    ps = __uint_as_float(rr[0]) + __uint_as_float(rr[1]); }
  l_reg = l_reg * alpha + ps;
#define PK4(P, BASE, OUT) do { unsigned a0 = cvtpk(P[BASE + 0], P[BASE + 1]), a1 = cvtpk(P[BASE + 2], P[BASE + 3]);   \
    unsigned b0 = cvtpk(P[BASE + 4], P[BASE + 5]), b1 = cvtpk(P[BASE + 6], P[BASE + 7]);                              \
    auto r0 = __builtin_amdgcn_permlane32_swap(a0, b0, false, false); auto r1 = __builtin_amdgcn_permlane32_swap(a1, b1, false, false); \
    u32x4 w = {r0[0], r1[0], r0[1], r1[1]}; OUT = *reinterpret_cast<bf16x8*>(&w); } while (0)
  PK4(p0, 0, pa0); PK4(p0, 8, pa1); PK4(p1, 0, pa2); PK4(p1, 8, pa3);
#undef PK4
}
__device__ __forceinline__ void qkt(f32x16& p0, f32x16& p1, const bf16* Ks, const bf16x8* qr, int r32, int hi) {
  p0 = f32x16{}; p1 = f32x16{};
  for (int d0 = 0; d0 < 8; ++d0) { int cb = (d0 * 16 + hi * 8) * 2;
    bf16x8 b0 = *reinterpret_cast<const bf16x8*>((const char*)Ks + KSWZ(r32, cb));
    bf16x8 b1 = *reinterpret_cast<const bf16x8*>((const char*)Ks + KSWZ(32 + r32, cb));
    p0 = __builtin_amdgcn_mfma_f32_32x32x16_bf16(b0, qr[d0], p0, 0, 0, 0);
    p1 = __builtin_amdgcn_mfma_f32_32x32x16_bf16(b1, qr[d0], p1, 0, 0, 0); }
}
__device__ __forceinline__ int v_st(int k, int c) { const int kk = (k & ~0xC) | ((k & 4) << 1) | ((k & 8) >> 1); return ((kk >> 3) * 4 + (c >> 5)) * 512 + ((kk & 7) * 32 + (c & 31)) * 2; }
__device__ __forceinline__ int v_rd_base(int lane) { return ((lane & 3) << 3) | (((lane >> 2) & 3) << 6) | (((lane >> 4) & 1) << 5) | (((lane >> 5) & 1) << 8); }
constexpr int v_rd_off(int d0, int ks, int half) { return d0 * 512 + ks * 4096 + half * 2048; }
template <int OFF> __device__ __forceinline__ s16x4 tr_read(int vb) {
  s16x4 r; asm volatile("ds_read_b64_tr_b16 %0, %1 offset:%2" : "=&v"(r) : "v"(vb), "i"(OFF) : "memory"); return r;
}
template <int D0> __device__ __forceinline__ void pv_one(f32x16& od, int vb, bf16x8 pa0, bf16x8 pa1, bf16x8 pa2, bf16x8 pa3) {
  const s16x4 l0 = tr_read<v_rd_off(D0, 0, 0)>(vb), h0 = tr_read<v_rd_off(D0, 0, 1)>(vb), l1 = tr_read<v_rd_off(D0, 1, 0)>(vb), h1 = tr_read<v_rd_off(D0, 1, 1)>(vb);
  const s16x4 l2 = tr_read<v_rd_off(D0, 2, 0)>(vb), h2 = tr_read<v_rd_off(D0, 2, 1)>(vb), l3 = tr_read<v_rd_off(D0, 3, 0)>(vb), h3 = tr_read<v_rd_off(D0, 3, 1)>(vb);
  asm volatile("s_waitcnt lgkmcnt(0)" ::: "memory"); SBAR();
#define PK(L, H) (bf16x8){L[0], L[1], L[2], L[3], H[0], H[1], H[2], H[3]}
  od = __builtin_amdgcn_mfma_f32_32x32x16_bf16(pa0, PK(l0, h0), od, 0, 0, 0);
  od = __builtin_amdgcn_mfma_f32_32x32x16_bf16(pa1, PK(l1, h1), od, 0, 0, 0);
  od = __builtin_amdgcn_mfma_f32_32x32x16_bf16(pa2, PK(l2, h2), od, 0, 0, 0);
  od = __builtin_amdgcn_mfma_f32_32x32x16_bf16(pa3, PK(l3, h3), od, 0, 0, 0);
#undef PK
}
__device__ __forceinline__ void pv_d0(f32x16* o, int vb, bf16x8 pa0, bf16x8 pa1, bf16x8 pa2, bf16x8 pa3) {
  pv_one<0>(o[0], vb, pa0, pa1, pa2, pa3); pv_one<1>(o[1], vb, pa0, pa1, pa2, pa3); pv_one<2>(o[2], vb, pa0, pa1, pa2, pa3); pv_one<3>(o[3], vb, pa0, pa1, pa2, pa3);
}
__device__ __forceinline__ void attn_dense_body(const bf16* __restrict__ Qb, const bf16* __restrict__ Kh, const bf16* __restrict__ Vh,
                                                bf16_t* __restrict__ Ob, int seq, char* lds, const int tid) {
  constexpr int SDEPTH = ATT_SDEPTH;
  const int wid = tid >> 6, lane = tid & 63, r32 = lane & 31, hi = lane >> 5;
  bf16* V_lds = (bf16*)lds; bf16* K_lds = (bf16*)(lds + 2 * SHM_V);
  float* ws = (float*)(lds + 2 * SHM_V + 2 * SHM_K) + wid * 64; float* li_l = ws; float* al_l = ws + 32;
  float m_reg = -1e30f, l_reg = 0; f32x16 o[4] = {}; bf16x8 qr[8];
  const bf16* Qw = Qb + (long)(wid * QBLK + r32) * LDQ + hi * 8;
#pragma unroll
  for (int d0 = 0; d0 < 8; ++d0) qr[d0] = ld8(Qw + d0 * 16);
  const int sr = tid >> 4, sc = (tid & 15) * 8, vst0 = v_st(sr, sc), vst1 = v_st(32 + sr, sc);
  const int vb0 = (int)(uintptr_t)V_lds + v_rd_base(lane);
  struct { bf16x8 vs0, vs1, ks0, ks1; } sr_[SDEPTH];
  const unsigned loff = (unsigned)(sr * LDK + sc) * 2u;
#define SLOAD(i, k0) do { const char* vb_ = (const char*)(Vh + (long)(k0) * LDK); const char* kb_ = (const char*)(Kh + (long)(k0) * LDK); \
    sr_[i].vs0 = *(const bf16x8*)(vb_ + loff); sr_[i].vs1 = *(const bf16x8*)(vb_ + 32 * LDK * 2 + loff); \
    sr_[i].ks0 = *(const bf16x8*)(kb_ + loff); sr_[i].ks1 = *(const bf16x8*)(kb_ + 32 * LDK * 2 + loff); } while (0)
#define SWRITE(b, i) do { *(bf16x8*)((char*)V_lds + (b) * SHM_V + vst0) = sr_[i].vs0;          \
    *(bf16x8*)((char*)V_lds + (b) * SHM_V + vst1) = sr_[i].vs1; int kc = sc * 2;               \
    *(bf16x8*)((char*)K_lds + (b) * SHM_K + KSWZ(sr, kc)) = sr_[i].ks0;                       \
    *(bf16x8*)((char*)K_lds + (b) * SHM_K + KSWZ(32 + sr, kc)) = sr_[i].ks1; } while (0)
#define SWAIT() do { if constexpr (SDEPTH == 2) asm volatile("s_waitcnt vmcnt(4)" ::: "memory"); else asm volatile("s_waitcnt vmcnt(0)" ::: "memory"); } while (0)
#define RESC(a) do { if (__any((a) < 1.f)) { if (hi == 0) al_l[r32] = (a); asm volatile("s_waitcnt lgkmcnt(0)" ::: "memory"); \
    for (int d = 0; d < 4; ++d) for (int r = 0; r < 16; ++r) o[d][r] *= al_l[crow(r, hi)]; } } while (0)
  f32x16 pA0, pA1, pB0, pB1; float mnA, mnB, alA, alB; bf16x8 pa0, pa1, pa2, pa3; const int NT = seq / KVBLK;
  constexpr int SE = 0, SO = SDEPTH - 1;
  SLOAD(SE, 0); asm volatile("s_waitcnt vmcnt(0)" ::: "memory"); SWRITE(0, SE); __syncthreads();
  qkt(pA0, pA1, K_lds, qr, r32, hi); partialSM(pA0, pA1, m_reg, mnA, alA);
  SLOAD(SO, KVBLK); if constexpr (SDEPTH == 2) { if (2 < NT) SLOAD(SE, 2 * KVBLK); }
  SWAIT(); SWRITE(1, SO); __syncthreads();
  for (int j = 1; j + 1 < NT; j += 2) {
    SBAR(); qkt(pB0, pB1, (bf16*)((char*)K_lds + SHM_K), qr, r32, hi);
    finishSM(pA0, pA1, alA, l_reg, pa0, pa1, pa2, pa3); SBAR();
    SLOAD(SO, (j + SDEPTH) * KVBLK); SBAR();
    pv_d0(o, vb0, pa0, pa1, pa2, pa3); partialSM(pB0, pB1, m_reg, mnB, alB);
    __syncthreads(); SWAIT(); SWRITE(0, SE);
    RESC(alB); __syncthreads();
    SBAR(); qkt(pA0, pA1, K_lds, qr, r32, hi);
    finishSM(pB0, pB1, alB, l_reg, pa0, pa1, pa2, pa3); SBAR();
    if (SDEPTH == 1 || j + 3 < NT) SLOAD(SE, (j + 1 + SDEPTH) * KVBLK); SBAR();
    pv_d0(o, vb0 + (int)SHM_V, pa0, pa1, pa2, pa3); partialSM(pA0, pA1, m_reg, mnA, alA);
    __syncthreads(); SWAIT(); SWRITE(1, SO);
    RESC(alA); __syncthreads();
  }
  SBAR(); qkt(pB0, pB1, (bf16*)((char*)K_lds + SHM_K), qr, r32, hi);
  finishSM(pA0, pA1, alA, l_reg, pa0, pa1, pa2, pa3); SBAR();
  pv_d0(o, vb0, pa0, pa1, pa2, pa3); partialSM(pB0, pB1, m_reg, mnB, alB);
  __syncthreads(); RESC(alB);
  finishSM(pB0, pB1, alB, l_reg, pa0, pa1, pa2, pa3); SBAR();
  pv_d0(o, vb0 + (int)SHM_V, pa0, pa1, pa2, pa3);
  if (hi == 0) li_l[r32] = l_reg; asm volatile("s_waitcnt lgkmcnt(0)" ::: "memory");
  float rli[16];
#pragma unroll
  for (int r = 0; r < 16; ++r) rli[r] = __builtin_amdgcn_rcpf(li_l[crow(r, hi)]);
  bf16_t* Ow = Ob + (long)(wid * QBLK) * LDO;
#pragma unroll
  for (int r = 0; r < 16; ++r) { int orow = crow(r, hi);
    for (int d0 = 0; d0 < 4; ++d0) Ow[(long)orow * LDO + d0 * 32 + r32] = (bf16_t)(cvtpk(o[d0][r] * rli[r], 0.f) & 0xffffu); }
#undef SLOAD
#undef SWRITE
#undef SWAIT
#undef RESC
}
#undef KSWZ
#undef SBAR
}

template <bool GLU> __device__ __forceinline__ void p0_transpose_item(const float* W, int K, int N, bf16_t* WT, LAS float* scr, int item, int lane) {
    const int nblk = N / 32, kb = item / nblk, nb = item % nblk, k0 = 64 * kb, n0 = 32 * nb;
    const int n0d = !GLU ? n0 : (n0 < FFN ? (n0 >> 7) * 256 + (n0 & 127) : ((n0 - FFN) >> 7) * 256 + 128 + ((n0 - FFN) & 127));
    float v[32];
    const float* wp0 = W + (size_t)(k0 + (lane >> 5)) * N + n0 + (lane & 31);
#pragma unroll
    for (int i = 0; i < 32; ++i) v[i] = wp0[(size_t)(2 * i) * N];
#pragma unroll
    for (int i = 0; i < 32; ++i) scr[(2 * i + (lane >> 5)) * 33 + (lane & 31)] = v[i];
    asm volatile("s_waitcnt lgkmcnt(0)" ::: "memory");
    const int c = lane & 7;
#pragma unroll
    for (int j = 0; j < 4; ++j) { const int n = (lane >> 3) + 8 * j; const LAS float* s = scr + (8 * c) * 33 + n;
        u32x4 o; o.x = cvt_pk_bf16(s[0 * 33], s[1 * 33]); o.y = cvt_pk_bf16(s[2 * 33], s[3 * 33]); o.z = cvt_pk_bf16(s[4 * 33], s[5 * 33]); o.w = cvt_pk_bf16(s[6 * 33], s[7 * 33]);
        *(u32x4*)(WT + (size_t)(n0d + n) * K + k0 + 8 * c) = o; }
    asm volatile("s_waitcnt lgkmcnt(0)" ::: "memory");
}

__device__ __forceinline__ void phase0(KP pp, LAS unsigned char* lds, int G, const int tid, const int bid) {
    const int lane = tid & 63, wave = tid >> 6;
    unsigned char* ws = pp->ws;
    LAS float* sv = (LAS float*)lds;
    for (int i = tid; i < 9 * DM; i += NTHREADS) { const int r = i / DM, k = i % DM; const float v = r < 8 ? pp->in[1][r * DM + k] : pp->in[3][k];
        sv[i] = v / (1.f + __expf(-v)); }
    __syncthreads();
    {
        const float* wmod = pp->in[4]; float* part = (float*)(ws + WS_MODP);
        LAS float* red = (LAS float*)(lds + 9 * DM * 4);
        const int grp = tid >> 7, t7 = tid & 127;
        for (int it = bid; it < 768; it += G) {
            const int L = it / 384, rem = it % 384, cb = rem % 24, kc = rem / 24;
            const int col = cb * 512 + t7 * 4, kb = kc * 128 + grp * 32;
            f32x4 acc[9];
#pragma unroll
            for (int r = 0; r < 9; ++r) acc[r] = (f32x4){0.f, 0.f, 0.f, 0.f};
            const float* wp = wmod + ((size_t)L * DM + kb) * NMODC + col;
#pragma unroll 8
            for (int k = 0; k < 32; ++k) { const f32x4 w = *(const f32x4*)(wp + (size_t)k * NMODC);
#pragma unroll
                for (int r = 0; r < 9; ++r) acc[r] += w * sv[r * DM + kb + k]; }
            if (grp > 0) {
#pragma unroll
                for (int r = 0; r < 9; ++r) *(LAS f32x4*)(red + ((grp - 1) * 9 + r) * 512 + t7 * 4) = acc[r];
            }
            __syncthreads();
            if (grp == 0) {
#pragma unroll
                for (int r = 0; r < 9; ++r) { f32x4 a = acc[r];
#pragma unroll
                    for (int g2 = 0; g2 < 3; ++g2) a += *(const LAS f32x4*)(red + (g2 * 9 + r) * 512 + t7 * 4);
                    *(f32x4*)(part + ((size_t)(kc * 2 + L) * 9 + r) * NMODC + col) = a; }
            }
            __syncthreads();
        }
    }
    __syncthreads();
    {
        LAS float* scr = (LAS float*)(lds + wave * 16384);
        const int gw = bid * NWAVES + wave, NGW = G * NWAVES;
        constexpr int I_IN = (DM / 64) * (INW / 32), I_OUT = (DM / 64) * (DM / 32), I_UP = (DM / 64) * (UPW / 32), I_DN = (FFN / 64) * (DM / 32);
        constexpr int PER = I_IN + I_OUT + I_UP + I_DN;
        for (int it = gw; it < 2 * PER; it += NGW) {
            const int L = it / PER; int r = it % PER;
            if (r < I_IN) { p0_transpose_item<false>(pp->in[10] + (size_t)L * DM * INW, DM, INW, (bf16_t*)(ws + WS_WIN) + (size_t)L * INW * DM, scr, r, lane); continue; } r -= I_IN;
            if (r < I_OUT) { p0_transpose_item<false>(pp->in[16] + (size_t)L * DM * DM, DM, DM, (bf16_t*)(ws + WS_WOUT) + (size_t)L * DM * DM, scr, r, lane); continue; } r -= I_OUT;
            if (r < I_UP) { p0_transpose_item<true>(pp->in[17] + (size_t)L * DM * UPW, DM, UPW, (bf16_t*)(ws + WS_WUP) + (size_t)L * UPW * DM, scr, r, lane); continue; } r -= I_UP;
            p0_transpose_item<false>(pp->in[20] + (size_t)L * FFN * DM, FFN, DM, (bf16_t*)(ws + WS_WDN) + (size_t)L * DM * FFN, scr, r, lane);
        }
    }
    __syncthreads();
    {
        const int gt = bid * NTHREADS + tid, NGT = G * NTHREADS;
        bf16_t* d2048 = (bf16_t*)(ws + WS_D2048);
        for (int it = gt; it < 2048 * 2048 / 8; it += NGT) {
            const int r = it / 256, t0 = (it % 256) * 8, k = r & 1023; float v[8];
#pragma unroll
            for (int e = 0; e < 8; ++e) { const float rev = (float)((k * (t0 + e)) & 2047) * (1.f / 2048.f);
                v[e] = r < 1024 ? __builtin_amdgcn_cosf(rev) : __builtin_amdgcn_sinf(rev); }
            u32x4 o; o.x = cvt_pk_bf16(v[0], v[1]); o.y = cvt_pk_bf16(v[2], v[3]); o.z = cvt_pk_bf16(v[4], v[5]); o.w = cvt_pk_bf16(v[6], v[7]);
            *(u32x4*)(d2048 + (size_t)r * 2048 + t0) = o;
        }
        bf16_t* d256 = (bf16_t*)(ws + WS_D256);
        for (int it = gt; it < 256 * 512 / 8; it += NGT) {
            const int k = it / 64, tt0 = (it % 64) * 8; float v[8];
#pragma unroll
            for (int e = 0; e < 8; ++e) { const int tt = tt0 + e, t = tt & 255; const float rev = (float)((k * t) & 255) * (1.f / 256.f);
                v[e] = tt < 256 ? __builtin_amdgcn_cosf(rev) : -__builtin_amdgcn_sinf(rev); }
            u32x4 o; o.x = cvt_pk_bf16(v[0], v[1]); o.y = cvt_pk_bf16(v[2], v[3]); o.z = cvt_pk_bf16(v[4], v[5]); o.w = cvt_pk_bf16(v[6], v[7]);
            *(u32x4*)(d256 + (size_t)k * 512 + tt0) = o;
        }
        LAS float* tab = (LAS float*)lds;
        LAS float* wl = (LAS float*)lds + 256;
        const float* wf = pp->in[13]; bf16_t* cws = (bf16_t*)(ws + WS_CWS);
        for (int it = bid; it < 256; it += G) {
            const int lg = it >> 4, half = (it >> 3) & 1, cblk = it & 7;
            __syncthreads();
            if (tid < 128) { const float rev = (float)tid * (1.f / 128.f); tab[tid] = __builtin_amdgcn_cosf(rev); tab[128 + tid] = __builtin_amdgcn_sinf(rev); }
#pragma unroll
            for (int i = 0; i < 8; ++i) *(LAS f32x4*)(wl + (i * 512 + tid) * 4) = *(const f32x4*)(wf + (size_t)lg * 16384 + (i * 512 + tid) * 4);
            __syncthreads();
            const int d = tid & 127, c0 = cblk * 16 + (tid >> 7) * 4;
            const LAS float* tb = tab + half * 128;
            float s0 = 0.f, s1 = 0.f, s2 = 0.f, s3 = 0.f;
#pragma unroll 8
            for (int l = 0; l < 128; ++l) { const float w = wl[l * 128 + d];
                s0 += tb[(l * c0) & 127] * w; s1 += tb[(l * (c0 + 1)) & 127] * w; s2 += tb[(l * (c0 + 2)) & 127] * w; s3 += tb[(l * (c0 + 3)) & 127] * w; }
            u32x2 o; o.x = cvt_pk_bf16(s0, s1); o.y = cvt_pk_bf16(s2, s3);
            *(u32x2*)(cws + ((size_t)lg * 256 + half * 128 + d) * 128 + c0) = o;
        }
    }
}

__device__ __forceinline__ void phase0b(KP pp, int G, const int tid, const int bid) {
    const int gt = bid * NTHREADS + tid, NGT = G * NTHREADS;
    const float* part = (const float*)(pp->ws + WS_MODP); float* mod = (float*)(pp->ws + WS_MOD); const float* bmod = pp->in[5];
    for (int i = gt; i < 2 * 9 * NMODC; i += NGT) {
        const int col = i % NMODC, L = i / (9 * NMODC);
        float s = bmod[L * NMODC + col];
#pragma unroll
        for (int kc = 0; kc < 16; ++kc) s += part[(size_t)kc * 2 * 9 * NMODC + i];
        mod[i] = s;
    }
}

struct RM {
    int nrows;
    const float* srcL; const float* srcC; const bf16_t* srcB; float* dstF; bf16_t* dstB;
    const bf16_t* y; const bf16_t* ysplit; const float* gate; const float* gpost;
    bf16_t* H; const float* gpre; const float* shift; const float* scale;
};
__device__ __forceinline__ void resid_mod(const RM& a, int G, const int tid, const int bid) {
    const int lane = tid & 63, gw = bid * NWAVES + (tid >> 6), NGW = G * NWAVES;
    for (int row = gw; row < a.nrows; row += NGW) {
        const bool lat = row < ML; const int mr = lat ? row / SEQ : 8;
        f32x4 x[8];
        if (a.srcB) {
            u32x2 w[8];
#pragma unroll
            for (int j = 0; j < 8; ++j) w[j] = *(const u32x2*)(a.srcB + (size_t)row * DM + j * 256 + lane * 4);
#pragma unroll
            for (int j = 0; j < 8; ++j) x[j] = (f32x4){bf_lo(w[j].x), bf_hi(w[j].x), bf_lo(w[j].y), bf_hi(w[j].y)};
        } else {
            const float* src = lat ? a.srcL + (size_t)row * DM : a.srcC + (size_t)(row - ML) * DM;
#pragma unroll
            for (int j = 0; j < 8; ++j) x[j] = *(const f32x4*)(src + j * 256 + lane * 4);
        }
        if (a.y) {
            const bf16_t* yr = a.y + (size_t)row * DM; f32x4 yv[8]; float ss = 0.f;
            if (lat || !a.ysplit) {
                u32x2 w[8];
#pragma unroll
                for (int j = 0; j < 8; ++j) w[j] = *(const u32x2*)(yr + j * 256 + lane * 4);
#pragma unroll
                for (int j = 0; j < 8; ++j) yv[j] = (f32x4){bf_lo(w[j].x), bf_hi(w[j].x), bf_lo(w[j].y), bf_hi(w[j].y)};
            } else {
#pragma unroll
                for (int j = 0; j < 8; ++j) yv[j] = (f32x4){0.f, 0.f, 0.f, 0.f};
#pragma unroll
                for (int ks = 0; ks < 4; ++ks) {
                    u32x2 w[8];
#pragma unroll
                    for (int j = 0; j < 8; ++j) w[j] = *(const u32x2*)(a.ysplit + ((size_t)ks * MC + (row - ML)) * DM + j * 256 + lane * 4);
#pragma unroll
                    for (int j = 0; j < 8; ++j) yv[j] += (f32x4){bf_lo(w[j].x), bf_hi(w[j].x), bf_lo(w[j].y), bf_hi(w[j].y)};
                }
            }
#pragma unroll
            for (int j = 0; j < 8; ++j) ss += (yv[j].x * yv[j].x + yv[j].y * yv[j].y) + (yv[j].z * yv[j].z + yv[j].w * yv[j].w);
            const float rstd = __builtin_amdgcn_rsqf(wave_sum(ss) * (1.f / DM) + EPS);
            const float* gt = a.gate + (size_t)mr * NMODC;
#pragma unroll
            for (int j = 0; j < 8; ++j) { const int e = j * 256 + lane * 4; const f32x4 g = *(const f32x4*)(gt + e), gp = *(const f32x4*)(a.gpost + e);
                x[j] = x[j] + g * (yv[j] * rstd * gp);
                if (a.dstB) { u32x2 w; w.x = cvt_pk_bf16(x[j].x, x[j].y); w.y = cvt_pk_bf16(x[j].z, x[j].w); *(u32x2*)(a.dstB + (size_t)row * DM + e) = w;
                    x[j] = (f32x4){bf_lo(w.x), bf_hi(w.x), bf_lo(w.y), bf_hi(w.y)}; }
                else *(f32x4*)(a.dstF + (size_t)row * DM + e) = x[j]; }
        }
        if (a.H) {
            float ss = 0.f;
#pragma unroll
            for (int j = 0; j < 8; ++j) ss += (x[j].x * x[j].x + x[j].y * x[j].y) + (x[j].z * x[j].z + x[j].w * x[j].w);
            const float rstd = __builtin_amdgcn_rsqf(wave_sum(ss) * (1.f / DM) + EPS);
            const float* sh = a.shift + (size_t)mr * NMODC; const float* scl = a.scale + (size_t)mr * NMODC; bf16_t* hr = a.H + (size_t)row * DM;
#pragma unroll
            for (int j = 0; j < 8; ++j) { const int e = j * 256 + lane * 4; const f32x4 g = *(const f32x4*)(a.gpre + e), s1 = *(const f32x4*)(scl + e), s0 = *(const f32x4*)(sh + e);
                const f32x4 h = (x[j] * rstd * g) * (s1 + 1.f) + s0; u32x2 w; w.x = cvt_pk_bf16(h.x, h.y); w.y = cvt_pk_bf16(h.z, h.w);
                *(u32x2*)(hr + e) = w; }
        }
    }
}

__device__ __forceinline__ void merge_phase(const bf16_t* attO, const bf16_t* fourO, const float* nyq, const float* gattn, const float* gfour, bf16_t* Y, int nrows, int G, const int tid, const int bid) {
    const int lane = tid & 63, gw = bid * NWAVES + (tid >> 6), NGW = G * NWAVES;
    for (int row = gw; row < nrows; row += NGW) {
        f32x4 a[4], f[4]; float sa = 0.f, sf = 0.f;
#pragma unroll
        for (int j = 0; j < 4; ++j) { const u32x2 w = *(const u32x2*)(attO + (size_t)row * 1024 + j * 256 + lane * 4); a[j] = (f32x4){bf_lo(w.x), bf_hi(w.x), bf_lo(w.y), bf_hi(w.y)}; }
        if (row < ML) {
            const int b = row >> 11, k = row & 2047, kk = k <= 1024 ? k : 2048 - k; const float sg = k <= 1024 ? -1.f : 1.f;
            const bool hasS = (kk != 0 && kk != 1024);
            const bf16_t* crow = fourO + ((size_t)b * 2048 + (kk < 1024 ? kk : 0)) * 1024; const bf16_t* srow = fourO + ((size_t)b * 2048 + 1024 + (hasS ? kk : 0)) * 1024;
            u32x2 wc[4], wsn[4];
#pragma unroll
            for (int j = 0; j < 4; ++j) { wc[j] = *(const u32x2*)(crow + j * 256 + lane * 4); wsn[j] = *(const u32x2*)(srow + j * 256 + lane * 4); }
#pragma unroll
            for (int j = 0; j < 4; ++j) { f32x4 c = (f32x4){bf_lo(wc[j].x), bf_hi(wc[j].x), bf_lo(wc[j].y), bf_hi(wc[j].y)};
                if (kk == 1024) c = *(const f32x4*)(nyq + b * 1024 + j * 256 + lane * 4);
                const f32x4 sv = (f32x4){bf_lo(wsn[j].x), bf_hi(wsn[j].x), bf_lo(wsn[j].y), bf_hi(wsn[j].y)};
                f[j] = hasS ? c + sv * sg : c; }
        } else {
#pragma unroll
            for (int j = 0; j < 4; ++j) { const u32x2 w = *(const u32x2*)(fourO + (size_t)row * 1024 + j * 256 + lane * 4); f[j] = (f32x4){bf_lo(w.x), bf_hi(w.x), bf_lo(w.y), bf_hi(w.y)}; }
        }
#pragma unroll
        for (int j = 0; j < 4; ++j) {
            sa += (a[j].x * a[j].x + a[j].y * a[j].y) + (a[j].z * a[j].z + a[j].w * a[j].w);
            sf += (f[j].x * f[j].x + f[j].y * f[j].y) + (f[j].z * f[j].z + f[j].w * f[j].w); }
        const float ra = __builtin_amdgcn_rsqf(wave_sum(sa) * (1.f / 1024.f) + EPS), rf = __builtin_amdgcn_rsqf(wave_sum(sf) * (1.f / 1024.f) + EPS);
        bf16_t* yr = Y + (size_t)row * DM;
#pragma unroll
        for (int j = 0; j < 4; ++j) { const int e = j * 256 + lane * 4; const f32x4 ga = *(const f32x4*)(gattn + e), gf = *(const f32x4*)(gfour + e);
            const f32x4 va = a[j] * ra * ga, vf = f[j] * rf * gf; u32x2 w; w.x = cvt_pk_bf16(va.x, va.y); w.y = cvt_pk_bf16(va.z, va.w); *(u32x2*)(yr + e) = w;
            w.x = cvt_pk_bf16(vf.x, vf.y); w.y = cvt_pk_bf16(vf.z, vf.w); *(u32x2*)(yr + 1024 + e) = w; }
    }
}

__device__ __forceinline__ void nyq_phase(const bf16_t* YTL, float* nyq, int G, const int tid, const int bid) {
    const int lane = tid & 63, gw = bid * NWAVES + (tid >> 6), NGW = G * NWAVES;
    for (int idx = gw; idx < NB * 1024; idx += NGW) {
        const int b = idx >> 10, ch = idx & 1023;
        const bf16_t* r = YTL + ((size_t)(b * 2) * 1024 + ch) * SEQ + lane * 8;
        float s = 0.f;
#pragma unroll
        for (int i = 0; i < 4; ++i) { const u32x4 w = *(const u32x4*)(r + i * 512);
            s += (bf_lo(w.x) - bf_hi(w.x)) + (bf_lo(w.y) - bf_hi(w.y)) + (bf_lo(w.z) - bf_hi(w.z)) + (bf_lo(w.w) - bf_hi(w.w)); }
        s = wave_sum(s);
        if (lane == 0) nyq[idx] = s * (1.f / 512.f);
    }
}

__device__ __forceinline__ void glufix_phase(bf16_t* Aact, const float* zp, const float* gv, const float* vv, const float* cw, int nrows, int G, const int tid, const int bid) {
    const int gt = bid * NTHREADS + tid, NGT = G * NTHREADS;
    constexpr int NC4 = FFN / 4;
    const int nitems = (nrows / 256) * 4 * NC4;
    for (int it = gt; it < nitems; it += NGT) {
        const int brow = it / NC4, col = (it % NC4) * 4, k = brow & 3, pm = brow >> 2;
        const int r = pm * 256 + (k == 0 ? 0 : k == 1 ? 127 : k == 2 ? 128 : 255);
        const int slen = r < ML ? SEQ : CTXL;
        f32x4 miss = (f32x4){0.f, 0.f, 0.f, 0.f}; const float* wsel = cw + ((k & 1) ? 2 * FFN : 0) + col;
        if (k == 0) { if ((r % slen) != 0) miss = *(const f32x4*)(gv + (size_t)(brow - 1) * FFN + col); }
        else if (k == 3) { if (((r + 1) % slen) != 0) miss = *(const f32x4*)(gv + (size_t)(brow + 1) * FFN + col); }
        else miss = *(const f32x4*)(gv + (size_t)(k == 1 ? brow + 1 : brow - 1) * FFN + col);
        const f32x4 z = *(const f32x4*)(zp + (size_t)brow * FFN + col) + miss * *(const f32x4*)wsel, v = *(const f32x4*)(vv + (size_t)brow * FFN + col);
        u32x2 w; w.x = cvt_pk_bf16(gelu_tanh(z.x) * v.x, gelu_tanh(z.y) * v.y); w.y = cvt_pk_bf16(gelu_tanh(z.z) * v.z, gelu_tanh(z.w) * v.w);
        *(u32x2*)(Aact + (size_t)r * FFN + col) = w;
    }
}

#define XB_TMO      128
#define XB_XCNT(j)  (256  + 64 * (j))
#define XB_XSUB(j)  (1280 + 64 * (j))
#define XB_XGEN(j)  (2304 + 64 * (j))
#define XB_TOP      3328
#define XB_TOPGEN   3392
#define XCD_BAR_WORDS 3456
#define XB_SPIN_CAP (1u << 18)
__device__ __forceinline__ unsigned xb_ld(unsigned* p)              { return __hip_atomic_load(p, __ATOMIC_RELAXED, __HIP_MEMORY_SCOPE_AGENT); }
__device__ __forceinline__ unsigned xb_add(unsigned* p, unsigned v) { return __hip_atomic_fetch_add(p, v, __ATOMIC_RELAXED, __HIP_MEMORY_SCOPE_AGENT); }
__device__ __forceinline__ unsigned xb_xcc_id() { return (unsigned)__builtin_amdgcn_s_getreg((3 << 11) | 20) & 0xFu; }
#define XB_SPIN(cond, bar) do { unsigned _sp = 0; while (cond) { __builtin_amdgcn_s_sleep(1); \
    if ((++_sp & 255u) == 0u) { if (xb_ld(&(bar)[XB_TMO])) break; if (_sp > XB_SPIN_CAP) { atomicAdd(&(bar)[XB_TMO], 1u); break; } } } } while (0)
struct XcdBarrier { unsigned* bar; unsigned x; volatile LAS unsigned* st; };
__device__ __forceinline__ void xcd_barrier_complete(unsigned* bar, unsigned x, unsigned& nloc, unsigned& nx) {
    const unsigned G = gridDim.x * gridDim.y * gridDim.z;
    unsigned sum, cnt, mine, sp = 0u;
    for (;;) {
        sum = 0u; cnt = 0u; mine = 0u;
#pragma unroll
        for (unsigned j = 0; j < 16; ++j) { const unsigned c = xb_ld(&bar[XB_XCNT(j)]); sum += c; cnt += (c > 0u) ? 1u : 0u; mine = (j == x) ? c : mine; }
        if (sum == G) break;
        __builtin_amdgcn_s_sleep(1);
        if ((++sp & 255u) == 0u) { if (xb_ld(&bar[XB_TMO])) break; if (sp > XB_SPIN_CAP) { atomicAdd(&bar[XB_TMO], 1u); break; } }
    }
    nloc = mine > 0u ? mine : 1u; nx = cnt > 0u ? cnt : 1u;
}
__device__ __forceinline__ void xcd_barrier(const XcdBarrier& b, const int tid) {
    asm volatile("s_waitcnt vmcnt(0)" ::: "memory");
    __syncthreads();
    if (tid == 0) {
        unsigned* bar = b.bar;
        __builtin_amdgcn_s_waitcnt(0);
        unsigned nloc = b.st[0], nx = b.st[1];
        if (nloc == 0u) { xcd_barrier_complete(bar, b.x, nloc, nx); b.st[0] = nloc; b.st[1] = nx; }
        const unsigned old = xb_add(&bar[XB_XSUB(b.x)], 1u);
        const unsigned gen = old / nloc;
        if (old + 1u == (gen + 1u) * nloc) {
            __builtin_amdgcn_fence(__ATOMIC_RELEASE, "agent");
            asm volatile("s_waitcnt vmcnt(0)" ::: "memory");
            const unsigned og = xb_add(&bar[XB_TOP], 1u);
            const unsigned tg = og / nx;
            if (og + 1u == (tg + 1u) * nx) xb_add(&bar[XB_TOPGEN], 1u);
            else XB_SPIN(xb_ld(&bar[XB_TOPGEN]) == tg, bar);
            __builtin_amdgcn_fence(__ATOMIC_ACQUIRE, "agent");
            xb_add(&bar[XB_XGEN(b.x)], 1u);
            asm volatile("s_waitcnt vmcnt(0)" ::: "memory");
        } else {
            XB_SPIN(xb_ld(&bar[XB_XGEN(b.x)]) == gen, bar);
            __builtin_amdgcn_fence(__ATOMIC_ACQUIRE, "agent");
            asm volatile("s_waitcnt vmcnt(0)" ::: "memory");
        }
    }
    __syncthreads();
}

enum { ST_P0 = 0, ST_P0B, ST_RM0, ST_G1, ST_QK, ST_ATT, ST_MRG, ST_G2, ST_RM1, ST_G3, ST_CGLU, ST_G4, ST_RM2 };

__global__ void __launch_bounds__(NTHREADS, 2) fwd_megakernel(Params p_arg) {
    (void)p_arg;
    extern __shared__ __attribute__((aligned(16))) unsigned char lds_raw[];
    cg::grid_group grid = cg::this_grid();
    const int G = gridDim.x;
    const int wv_u = __builtin_amdgcn_readfirstlane((int)(threadIdx.x >> 6));
    {
        volatile LAS unsigned* st0 = (volatile LAS unsigned*)((LAS unsigned char*)lds_raw + 131072);
        if (threadIdx.x < 2) st0[threadIdx.x] = 0u;
        __syncthreads();
        if (threadIdx.x == 0) { KP pp0 = (KP)__builtin_amdgcn_kernarg_segment_ptr(); (void)xb_add((unsigned*)pp0->ws + XB_XCNT(xb_xcc_id()), 1u); }
    }

    constexpr int NSTEPS = 3 + 10 * DEPTH;
#pragma unroll 1
    for (int step = 0; step < NSTEPS; ++step) {
        unsigned zv; asm volatile("v_mov_b32 %0, 0" : "=v"(zv));
        const int tid = wv_u * 64 + (int)__builtin_amdgcn_mbcnt_hi(~0u, __builtin_amdgcn_mbcnt_lo(~0u, zv));
        int bid = blockIdx.x; asm volatile("" : "+s"(bid));
        KP pp = (KP)__builtin_amdgcn_kernarg_segment_ptr(); asm volatile("" : "+s"(pp));
        unsigned char* ws = pp->ws;
        LAS unsigned char* lds = (LAS unsigned char*)lds_raw;
        float* mod = (float*)(ws + WS_MOD);
        bf16_t* Hb = (bf16_t*)(ws + WS_H); bf16_t* MIX = (bf16_t*)(ws + WS_MIX); bf16_t* U = (bf16_t*)(ws + WS_R1);
        bf16_t* Pb = (bf16_t*)(ws + WS_P); bf16_t* Qn = (bf16_t*)(ws + WS_QN); bf16_t* Kall = (bf16_t*)(ws + WS_KALL); bf16_t* Vall = (bf16_t*)(ws + WS_VALL);
        bf16_t* YTL = (bf16_t*)(ws + WS_YTL); bf16_t* YTC = (bf16_t*)(ws + WS_YTC); bf16_t* attO = (bf16_t*)(ws + WS_ATTO); bf16_t* fourO = (bf16_t*)(ws + WS_FOURO);
        bf16_t* XS = (bf16_t*)(ws + WS_XS); bf16_t* YPART = (bf16_t*)(ws + WS_YPART);
        const int kind = step < 3 ? step : 3 + (step - 3) % 10;
        const int L = step < 3 ? 0 : (step - 3) / 10;
        const bool lastL = (L == DEPTH - 1);
        const int mrows = lastL ? ML : MT;
        const float* modL = mod + (size_t)L * 9 * NMODC;
        int njobs = 0;
        if (kind == ST_P0) phase0(pp, lds, G, tid, bid);
        else if (kind == ST_P0B) phase0b(pp, G, tid, bid);
        else if (kind == ST_RM0 || kind == ST_RM1 || kind == ST_RM2) {
            RM a;
            a.srcL = pp->in[0]; a.srcC = pp->in[2]; a.srcB = nullptr; a.dstF = nullptr; a.dstB = nullptr; a.y = nullptr; a.ysplit = nullptr; a.gate = nullptr; a.gpost = nullptr;
            if (kind == ST_RM0) { a.nrows = MT; a.H = Hb; a.gpre = pp->in[6]; a.shift = mod; a.scale = mod + DM; }
            else if (kind == ST_RM1) { a.nrows = mrows; a.srcB = L == 0 ? nullptr : XS; a.dstB = XS; a.y = MIX; a.ysplit = lastL ? nullptr : YPART; a.gate = modL + 2 * DM; a.gpost = pp->in[7] + L * DM;
                a.H = Hb; a.gpre = pp->in[8] + L * DM; a.shift = modL + 3 * DM; a.scale = modL + 4 * DM; }
            else { a.nrows = mrows; a.srcB = XS; a.dstB = lastL ? nullptr : XS; a.dstF = pp->out; a.y = MIX; a.ysplit = lastL ? nullptr : YPART; a.gate = modL + 5 * DM; a.gpost = pp->in[9] + L * DM;
                a.H = lastL ? nullptr : Hb; a.gpre = pp->in[6] + (L + 1) * DM; a.shift = modL + 9 * NMODC; a.scale = modL + 9 * NMODC + DM; }
            resid_mod(a, G, tid, bid);
        }
        else if (kind == ST_QK) { njobs = 1; }
        else if (kind == ST_MRG) merge_phase(attO, fourO, (const float*)(ws + WS_NYQ), pp->in[14] + L * 1024, pp->in[15] + L * 1024, Hb, mrows, G, tid, bid);
        else if (kind == ST_CGLU) glufix_phase(U, (const float*)(ws + WS_ZP), (const float*)(ws + WS_GV), (const float*)(ws + WS_VV), pp->in[18] + (size_t)L * 3 * FFN, mrows, G, tid, bid);
        else if (kind == ST_ATT) {
            const int nunits = lastL ? 512 : 576;
            for (int u = bid; u < nunits; u += G) {
                const att::bf16 *Qb, *Kh, *Vh; bf16_t* Ob; int seq;
                if (u < 512) {
                    int pair, j;
                    if (G == 256) { const int i = u >> 8, cc = u & 255; pair = i * 8 + (cc & 7); j = cc >> 3; } else { pair = u >> 5; j = u & 31; }
                    const int b = pair >> 1, kvh = pair & 1, gq = j >> 3, qb = j & 7, h = kvh * 4 + gq;
                    const size_t qrow = (size_t)b * SEQ + qb * 256;
                    Qb = (const att::bf16*)(Qn + qrow * 1024 + h * 128); Ob = attO + qrow * 1024 + h * 128;
                    Kh = (const att::bf16*)(Kall + (size_t)b * SKV * 256 + kvh * 128); Vh = (const att::bf16*)(Vall + (size_t)b * SKV * 256 + kvh * 128); seq = SKV;
                } else {
                    const int v = u - 512, b = v >> 3, h = v & 7;
                    const size_t qrow = (size_t)ML + b * CTXL;
                    Qb = (const att::bf16*)(Qn + qrow * 1024 + h * 128); Ob = attO + qrow * 1024 + h * 128;
                    Kh = (const att::bf16*)(Kall + ((size_t)b * SKV + SEQ) * 256 + (h >> 2) * 128); Vh = (const att::bf16*)(Vall + ((size_t)b * SKV + SEQ) * 256 + (h >> 2) * 128); seq = CTXL;
                }
                att::attn_dense_body(Qb, Kh, Vh, Ob, seq, (char*)lds_raw, tid);
                __syncthreads();
            }
            nyq_phase(YTL, (float*)(ws + WS_NYQ), G, tid, bid);
            njobs = lastL ? 1 : 2;
        }
        else njobs = ((kind == ST_G2 || kind == ST_G4) && !lastL) ? 2 : 1;

        for (int j = 0; j < njobs; ++j) {
            pg8::Job J; J.ksplit = 1; J.ostride_ks = 0; J.amod = 1 << 30; J.bdiv = 1 << 30; J.bstride_m = 0; J.mode = 0; J.scale = 1.f; J.O2 = nullptr; J.cw = nullptr; J.cb = nullptr; J.zp = nullptr; J.gv = nullptr; J.vv = nullptr; J.qn = nullptr; J.kall = nullptr; J.vall = nullptr;
            if (kind == ST_G1) { J.A = Hb; J.lda = DM; J.B = (const bf16_t*)(ws + WS_WIN) + (size_t)L * INW * DM; J.ldb = DM; J.K = DM; J.nM = MT / 256; J.nN = INW / 256; J.O = Pb; J.ldc = INW; J.mode = 3; J.qn = Qn; J.kall = Kall; J.vall = Vall; }
            else if (kind == ST_QK) { J.A = (const bf16_t*)(ws + WS_CWS) + (size_t)L * 8 * 256 * 128; J.lda = 128; J.B = Pb + QKVW; J.ldb = INW; J.K = 128; J.nM = 8; J.nN = mrows / 256;
                J.bdiv = 1; J.bstride_m = 128; J.O = YTL; J.O2 = YTC; J.ldc = 0; J.mode = 1; }
            else if (kind == ST_ATT) {
                if (j == 0) { J.A = (const bf16_t*)(ws + WS_D2048); J.lda = 2048; J.amod = 8; J.B = YTL; J.ldb = 2048; J.bdiv = 4; J.bstride_m = (long)1024 * 2048; J.K = 2048; J.nM = 64; J.nN = 4;
                    J.O = fourO; J.ldc = 1024; J.scale = 1.f / 512.f; }
                else { J.A = (const bf16_t*)(ws + WS_D256); J.lda = 512; J.amod = 1; J.B = YTC; J.ldb = 512; J.bdiv = 1; J.bstride_m = (long)1024 * 512; J.K = 512; J.nM = 8; J.nN = 4;
                    J.O = fourO + (size_t)ML * 1024; J.ldc = 1024; J.scale = 0.005524271728019903f; }
            }
            else if (kind == ST_G2) { J.A = Hb; J.lda = DM; J.B = (const bf16_t*)(ws + WS_WOUT) + (size_t)L * DM * DM; J.ldb = DM; J.K = DM; J.nM = ML / 256; J.nN = DM / 256; J.O = MIX; J.ldc = DM;
                if (j == 1) { J.A = Hb + (size_t)ML * DM; J.nM = MC / 256; J.ksplit = 4; J.K = DM / 4; J.O = YPART; J.ostride_ks = (long)MC * DM; } }
            else if (kind == ST_G3) { J.A = Hb; J.lda = DM; J.B = (const bf16_t*)(ws + WS_WUP) + (size_t)L * UPW * DM; J.ldb = DM; J.K = DM; J.nM = mrows / 256; J.nN = UPW / 256; J.O = U; J.ldc = FFN; J.mode = 2;
                J.cw = pp->in[18] + (size_t)L * 3 * FFN; J.cb = pp->in[19] + (size_t)L * FFN; J.zp = (float*)(ws + WS_ZP); J.gv = (float*)(ws + WS_GV); J.vv = (float*)(ws + WS_VV); }
            else { J.A = U; J.lda = FFN; J.B = (const bf16_t*)(ws + WS_WDN) + (size_t)L * DM * FFN; J.ldb = FFN; J.K = FFN; J.nM = ML / 256; J.nN = DM / 256; J.O = MIX; J.ldc = DM;
                if (j == 1) { J.A = U + (size_t)ML * FFN; J.nM = MC / 256; J.ksplit = 4; J.K = FFN / 4; J.O = YPART; J.ostride_ks = (long)MC * DM; } }
            J.astride = (long)256 * J.lda; J.bstride_n = (long)256 * J.ldb;
            pg8::StaticOrder S; S.init(J.nM, J.nN * J.ksplit, G, bid);
            if (kind == ST_G1 && tid < 256) ((LAS float*)(lds + CWL_OFF))[tid] = tid < 128 ? pp->in[11][L * 128 + tid] : pp->in[12][L * 128 + tid - 128];
            __syncthreads();
            pg8::gemm_phase(lds, J, S, tid);
        }
        if (gridDim.y == 0x7fff) grid.sync();
        { XcdBarrier xb; xb.bar = (unsigned*)ws; xb.x = xb_xcc_id(); xb.st = (volatile LAS unsigned*)(lds + 131072); xcd_barrier(xb, tid); }
    }
}

extern "C" void kernel_launch(void* const* d_in, const int* in_sizes, int n_in, void* d_out, int out_size, void* d_ws, size_t ws_size, hipStream_t stream) {
    static int grid = 0;
    if (grid == 0) {
        if (n_in != 21 || out_size != ML * DM || ws_size < WS_END) { fprintf(stderr, "kernel_launch: unexpected shapes: n_in %d out %d ws %zu (need %zu)\n", n_in, out_size, ws_size, (size_t)WS_END); grid = -1; return; }
        int dev = 0, cus = 0, per_cu = 0;
        (void)hipGetDevice(&dev); (void)hipDeviceGetAttribute(&cus, hipDeviceAttributeMultiprocessorCount, dev);
        if (hipFuncSetAttribute((const void*)fwd_megakernel, hipFuncAttributeMaxDynamicSharedMemorySize, LDS_BYTES) != hipSuccess) { fprintf(stderr, "kernel_launch: hipFuncSetAttribute failed\n"); grid = -1; return; }
        if (hipOccupancyMaxActiveBlocksPerMultiprocessor(&per_cu, (const void*)fwd_megakernel, NTHREADS, LDS_BYTES) != hipSuccess || per_cu < 1) { fprintf(stderr, "kernel_launch: occupancy query gave %d\n", per_cu); (void)hipGetLastError(); per_cu = 1; }
        grid = cus;
        if (grid > cus * per_cu) grid = cus * per_cu;
    }
    if (grid < 0) return;
    if (hipMemsetAsync(d_ws, 0, 65536, stream) != hipSuccess) { fprintf(stderr, "kernel_launch: hipMemsetAsync failed\n"); return; }
    Params p{};
    for (int i = 0; i < 21; ++i) p.in[i] = (const float*)d_in[i];
    p.out = (float*)d_out; p.ws = (unsigned char*)d_ws;
    void* args[] = {&p};
    hipError_t e = hipLaunchCooperativeKernel((const void*)fwd_megakernel, dim3(grid), dim3(NTHREADS), args, LDS_BYTES, stream);
    if (e != hipSuccess) fprintf(stderr, "cooperative launch failed: %s (grid %d)\n", hipGetErrorString(e), grid);
}
```

```cpp
#include <hip/hip_runtime.h>
#include <hip/hip_bf16.h>
#include <hip/hip_cooperative_groups.h>
#include <cstdio>
#include <cstdint>
namespace cg = cooperative_groups;

constexpr int DM = 2048, NB = 8, SEQ = 2048, CTXL = 256, DEPTH = 2;
constexpr int ML = NB * SEQ, MC = NB * CTXL, MT = ML + MC;
constexpr int INW = 2560, QKVW = 1536, FFN = 5632, UPW = 2 * FFN, NMODC = 6 * DM;
constexpr int SKV = SEQ + CTXL;
constexpr float EPS = 1e-6f;
constexpr int NTHREADS = 512, NWAVES = 8;

#define LAS __attribute__((address_space(3)))
typedef unsigned short bf16_t;
typedef short bf16x8 __attribute__((ext_vector_type(8)));
typedef float f32x4 __attribute__((ext_vector_type(4)));
typedef float f32x2 __attribute__((ext_vector_type(2)));
typedef unsigned u32x4 __attribute__((ext_vector_type(4)));
typedef unsigned u32x2 __attribute__((ext_vector_type(2)));
using f32x16 = __attribute__((ext_vector_type(16))) float;
using s16x4 = __attribute__((ext_vector_type(4))) short;

constexpr size_t MiB = 1u << 20;
constexpr size_t WS_MOD = 1 * MiB;
constexpr size_t WS_MODP = 2 * MiB;
constexpr size_t WS_CWS = 16 * MiB;
constexpr size_t WS_D256 = 17 * MiB;
constexpr size_t WS_D2048 = 18 * MiB;
constexpr size_t WS_WIN = 34 * MiB;
constexpr size_t WS_WOUT = 54 * MiB;
constexpr size_t WS_WUP = 70 * MiB;
constexpr size_t WS_WDN = 158 * MiB;
constexpr size_t WS_XC = 202 * MiB;
constexpr size_t WS_H = 218 * MiB;
constexpr size_t WS_MIX = 290 * MiB;
constexpr size_t WS_R1 = 362 * MiB;
constexpr size_t WS_P = WS_R1;
constexpr size_t WS_QN = WS_R1 + 90 * MiB;
constexpr size_t WS_KALL = WS_R1 + 126 * MiB;
constexpr size_t WS_VALL = WS_R1 + 135 * MiB;
constexpr size_t WS_YTL = WS_R1 + 144 * MiB;
constexpr size_t WS_YTC = WS_R1 + 208 * MiB;
constexpr size_t WS_ATTO = WS_R1 + 216 * MiB;
constexpr size_t WS_FOURO = WS_R1 + 252 * MiB;
constexpr size_t WS_ZP = WS_R1 + 200 * MiB;
constexpr size_t WS_GV = WS_R1 + 207 * MiB;
constexpr size_t WS_VV = WS_R1 + 214 * MiB;
constexpr size_t WS_NYQ = 1 * MiB + 960 * 1024;
constexpr size_t WS_YPART = WS_R1 + 288 * MiB;
constexpr size_t WS_XS = WS_R1 + 320 * MiB;
constexpr size_t WS_END = WS_R1 + 396 * MiB;
constexpr int CWL_OFF = 131072 + 1024;
constexpr int QKP_OFF = CWL_OFF + 4096;
constexpr int LDS_BYTES = 131072 + 1024 + 4096 + 8192;

struct Params { const float* in[21]; float* out; unsigned char* ws; };
typedef const __attribute__((address_space(4))) Params* KP;

__device__ __forceinline__ unsigned cvt_pk_bf16(float lo, float hi) { unsigned r; asm volatile("v_cvt_pk_bf16_f32 %0, %1, %2" : "=v"(r) : "v"(lo), "v"(hi)); return r; }
__device__ __forceinline__ float bf_lo(unsigned w) { return __uint_as_float(w << 16); }
__device__ __forceinline__ float bf_hi(unsigned w) { return __uint_as_float(w & 0xffff0000u); }
__device__ __forceinline__ float wave_sum(float v) {
#pragma unroll
    for (int o = 1; o < 64; o <<= 1) v += __shfl_xor(v, o);
    return v;
}
__device__ __forceinline__ float gelu_tanh(float z) {
    const float t = z * (0.044715f * z * z + 1.f);
    const float e = __builtin_amdgcn_exp2f(t * (-2.f * 0.7978845608028654f * 1.4426950408889634f));
    return z * __builtin_amdgcn_rcpf(1.f + e);
}

namespace pg8 {
constexpr int BM = 256, BK = 64, HALF = 128, HTB = HALF * BK * 2, STAGE_BYTES = 8 * HTB, NXCD = 8, WGM = 8;
__device__ __forceinline__ int lds_byte(int r, int c) { const int st = (r >> 4) * 2 + (c >> 5), rr = r & 15, cc = c & 31, ob = rr * 64 + cc * 2; return st * 1024 + (ob ^ (((ob >> 9) & 1) << 5)); }
__device__ __forceinline__ void stage_rc(int b, int& R, int& C) { const int st = b / 1024, sb = b % 1024, swz = sb ^ (((sb >> 9) & 1) << 5); R = (st >> 1) * 16 + swz / 64; C = (st & 1) * 32 + (swz % 64) / 2; }
__device__ __forceinline__ int perm32(int rho) { const int n = rho >> 4, i = rho & 15; return 8 * (i >> 2) + 4 * n + (i & 3); }

struct Unit { int pm, pn, ks; };
struct Job {
    const bf16_t* A; const bf16_t* B; bf16_t* O;
    int lda, ldb, ldc, K, nM, nN;
    int ksplit; long ostride_ks;
    int amod, bdiv; long astride, bstride_m, bstride_n;
    int mode; float scale; bf16_t* O2;
    const float* cw; const float* cb; float* zp; float* gv; float* vv;
    const bf16_t* xs; float* outf; const float* gate; const float* gpost; float* xbuf; unsigned* pcnt;
    bf16_t* qn; bf16_t* kall; bf16_t* vall;
    __device__ __forceinline__ const char* aptr(const Unit& u) const { return (const char*)(A + (size_t)(u.pm % amod) * astride + (size_t)u.ks * K); }
    __device__ __forceinline__ const char* bptr(const Unit& u) const { return (const char*)(B + (size_t)(u.pm / bdiv) * bstride_m + (size_t)u.pn * bstride_n + (size_t)u.ks * K); }
};
struct StaticOrder {
    int nM, nN, nwg, G, c, panel;
    __device__ void init(int nM_, int nN_, int G_, int c_) { nM = nM_; nN = nN_; nwg = nM * nN; G = G_; c = c_; panel = 0; }
    __device__ bool next(int i, Unit& u) const {
        if (panel) { const int cp = (G % 8 == 0) ? (c % 8) * (G / 8) + c / 8 : c; const long Lp = (long)i * G + cp; if (Lp >= nwg) return false; u.pm = (int)(Lp / nN); u.pn = (int)(Lp % nN); u.ks = 0; return true; }
        const long L = (long)i * G + c; if (L >= nwg) return false;
        int wgid = (int)L; { const int q = nwg / NXCD, r = nwg % NXCD, xcd = wgid % NXCD, off = wgid / NXCD; wgid = (xcd < r ? xcd * (q + 1) : r * (q + 1) + (xcd - r) * q) + off; }
        const int nig = WGM * nN, gid = wgid / nig, fm = gid * WGM, gsz = (nM - fm) < WGM ? (nM - fm) : WGM;
        u.pm = fm + ((wgid % nig) % gsz); u.pn = (wgid % nig) / gsz; u.ks = 0; return true;
    }
};

__device__ __forceinline__ void epilogue(const Job& J, const f32x4 (&acc)[2][2][4][2], const Unit& u, int wr, int wc, int fr, int fq, LAS unsigned char* lds, int upar) {
    asm volatile("" : "+v"(fr), "+v"(fq));
    const float sc = J.scale;
    if (J.mode == 0 || (J.mode == 3 && u.pn >= 6)) {
        const int row0 = u.pm * BM + wr * 64 + fr, col0 = u.pn * BM + wc * 32 + 8 * fq;
#pragma unroll
        for (int ai = 0; ai < 2; ++ai)
#pragma unroll
            for (int m = 0; m < 4; ++m) { bf16_t* rowp = J.O + (size_t)u.ks * J.ostride_ks + (size_t)(row0 + ai * HALF + m * 16) * J.ldc + col0;
#pragma unroll
                for (int bj = 0; bj < 2; ++bj) { const f32x4 v0 = acc[ai][bj][m][0] * sc, v1 = acc[ai][bj][m][1] * sc;
                    u32x4 w; w.x = cvt_pk_bf16(v0[0], v0[1]); w.y = cvt_pk_bf16(v0[2], v0[3]); w.z = cvt_pk_bf16(v1[0], v1[1]); w.w = cvt_pk_bf16(v1[2], v1[3]);
                    *(u32x4*)(rowp + bj * HALF) = w; } }
    } else if (J.mode == 4) {
        const int lane = fq * 16 + fr, wid = wr * 4 + wc, rl0 = wr * 64 + fr;
        LAS float* part = (LAS float*)(lds + QKP_OFF);
        LAS float* Srs = part + 1024;
#pragma unroll
        for (int ai = 0; ai < 2; ++ai)
#pragma unroll
            for (int m = 0; m < 4; ++m) { float sq = 0.f;
#pragma unroll
                for (int bj = 0; bj < 2; ++bj)
#pragma unroll
                    for (int n = 0; n < 2; ++n) { const f32x4 a = acc[ai][bj][m][n]; sq += (a[0] * a[0] + a[1] * a[1]) + (a[2] * a[2] + a[3] * a[3]); }
                sq += __shfl_xor(sq, 16); sq += __shfl_xor(sq, 32);
                if (fq == 0) part[(rl0 + 128 * ai + 16 * m) * 4 + wc] = sq; }
        asm volatile("s_waitcnt lgkmcnt(0)" ::: "memory"); __builtin_amdgcn_s_barrier(); asm volatile("" ::: "memory");
        const int prow = wid * 32 + (lane & 31);
        if (lane < 32) { const f32x4 p4 = *(const LAS f32x4*)(part + prow * 4);
            __hip_atomic_store(J.xbuf + ((size_t)u.pm * BM + prow) * 8 + u.pn, (p4[0] + p4[1]) + (p4[2] + p4[3]), __ATOMIC_RELAXED, __HIP_MEMORY_SCOPE_AGENT); }
        asm volatile("s_waitcnt vmcnt(0)" ::: "memory");
        if (lane == 0) __hip_atomic_fetch_add(J.pcnt + 64 * u.pm, 1u, __ATOMIC_RELAXED, __HIP_MEMORY_SCOPE_AGENT);
        if (wid == 0) { unsigned sp = 0;
            while ((unsigned)__builtin_amdgcn_readfirstlane((int)__hip_atomic_load(J.pcnt + 64 * u.pm, __ATOMIC_RELAXED, __HIP_MEMORY_SCOPE_AGENT)) < 64u) { __builtin_amdgcn_s_sleep(2); if (++sp > (1u << 16)) break; }
            __builtin_amdgcn_fence(__ATOMIC_ACQUIRE, "agent"); }
        asm volatile("s_waitcnt vmcnt(0) lgkmcnt(0)" ::: "memory"); __builtin_amdgcn_s_barrier(); asm volatile("" ::: "memory");
        if (lane < 32) { const float* xb = J.xbuf + ((size_t)u.pm * BM + prow) * 8; float t = 0.f;
#pragma unroll
            for (int q = 0; q < 8; ++q) t += __hip_atomic_load(xb + q, __ATOMIC_RELAXED, __HIP_MEMORY_SCOPE_AGENT);
            Srs[prow] = __builtin_amdgcn_rsqf(t * (1.f / DM) + EPS); }
        asm volatile("s_waitcnt lgkmcnt(0)" ::: "memory"); __builtin_amdgcn_s_barrier(); asm volatile("" ::: "memory");
        const int col0 = u.pn * BM + wc * 32 + 8 * fq;
        const float* gt = J.gate + (size_t)(u.pm >> 3) * NMODC + col0; const float* gp = J.gpost + col0;
        float gg[2][8];
#pragma unroll
        for (int bj = 0; bj < 2; ++bj)
#pragma unroll
            for (int h = 0; h < 2; ++h) { const f32x4 a = *(const f32x4*)(gt + bj * HALF + 4 * h), b = *(const f32x4*)(gp + bj * HALF + 4 * h);
#pragma unroll
                for (int i = 0; i < 4; ++i) gg[bj][4 * h + i] = a[i] * b[i]; }
#pragma unroll
        for (int ai = 0; ai < 2; ++ai)
#pragma unroll
            for (int m = 0; m < 4; ++m) { const int r = rl0 + 128 * ai + 16 * m; const float rs = Srs[r]; const size_t off = ((size_t)u.pm * BM + r) * DM + col0;
#pragma unroll
                for (int bj = 0; bj < 2; ++bj) { const u32x4 xw = *(const u32x4*)(J.xs + off + bj * HALF);
                    const f32x4 a0 = acc[ai][bj][m][0], a1 = acc[ai][bj][m][1];
                    f32x4 o0, o1;
                    o0[0] = bf_lo(xw.x) + gg[bj][0] * rs * a0[0]; o0[1] = bf_hi(xw.x) + gg[bj][1] * rs * a0[1]; o0[2] = bf_lo(xw.y) + gg[bj][2] * rs * a0[2]; o0[3] = bf_hi(xw.y) + gg[bj][3] * rs * a0[3];
                    o1[0] = bf_lo(xw.z) + gg[bj][4] * rs * a1[0]; o1[1] = bf_hi(xw.z) + gg[bj][5] * rs * a1[1]; o1[2] = bf_lo(xw.w) + gg[bj][6] * rs * a1[2]; o1[3] = bf_hi(xw.w) + gg[bj][7] * rs * a1[3];
                    *(f32x4*)(J.outf + off + bj * HALF) = o0; *(f32x4*)(J.outf + off + bj * HALF + 4) = o1; }
                __builtin_amdgcn_sched_barrier(0); }
    } else if (J.mode == 3) {
        const bool lat = u.pm < 64, nrm = u.pn < 5;
        const int rl0 = wr * 64 + fr, cl = wc * 32 + 8 * fq;
        if (nrm) {
            LAS float* part = (LAS float*)(lds + QKP_OFF);
#pragma unroll
            for (int ai = 0; ai < 2; ++ai)
#pragma unroll
                for (int m = 0; m < 4; ++m)
#pragma unroll
                    for (int bj = 0; bj < 2; ++bj) { const f32x4 a = acc[ai][bj][m][0], b = acc[ai][bj][m][1];
                        float sq = (a[0] * a[0] + a[1] * a[1]) + (a[2] * a[2] + a[3] * a[3]) + (b[0] * b[0] + b[1] * b[1]) + (b[2] * b[2] + b[3] * b[3]);
                        sq += __shfl_xor(sq, 16); sq += __shfl_xor(sq, 32);
                        if (fq == 0) part[(rl0 + 128 * ai + 16 * m) * 8 + bj * 4 + wc] = sq; }
            asm volatile("s_waitcnt lgkmcnt(0)" ::: "memory"); __builtin_amdgcn_s_barrier(); asm volatile("" ::: "memory");
        }
        const LAS float* nw = (const LAS float*)(lds + CWL_OFF) + (u.pn == 4 ? 128 : 0) + cl;
        float gw[8];
        { const f32x4 a = *(const LAS f32x4*)nw, b = *(const LAS f32x4*)(nw + 4); gw[0] = a[0]; gw[1] = a[1]; gw[2] = a[2]; gw[3] = a[3]; gw[4] = b[0]; gw[5] = b[1]; gw[6] = b[2]; gw[7] = b[3]; }
        float frq[4];
#pragma unroll
        for (int i = 0; i < 4; ++i) frq[i] = __builtin_amdgcn_exp2f(-(float)((16 * wc + 4 * fq + i) & 31) * (13.287712379549449f / 32.f));
#pragma unroll
        for (int ai = 0; ai < 2; ++ai)
#pragma unroll
            for (int m = 0; m < 4; ++m) {
                const int rl = rl0 + 128 * ai + 16 * m, t = ((u.pm & 7) << 8) + rl;
                float cs[4], sn[4];
#pragma unroll
                for (int i = 0; i < 4; ++i) { cs[i] = 1.f; sn[i] = 0.f; }
                if (lat && nrm) { const float pos = (float)(wc < 2 ? (t >> 6) : (t & 63));
#pragma unroll
                    for (int i = 0; i < 4; ++i) { float rev = pos * frq[i] * 0.15915494309189535f; rev -= floorf(rev); cs[i] = __builtin_amdgcn_cosf(rev); sn[i] = __builtin_amdgcn_sinf(rev); } }
                const size_t row = (size_t)u.pm * BM + rl;
                const size_t kvrow = lat ? (size_t)(u.pm >> 3) * SKV + t : (size_t)(u.pm - 64) * SKV + SEQ + rl;
#pragma unroll
                for (int bj = 0; bj < 2; ++bj) {
                    float v[8];
#pragma unroll
                    for (int e = 0; e < 8; ++e) v[e] = acc[ai][bj][m][e >> 2][e & 3];
                    if (nrm) { const f32x4 p4 = *(const LAS f32x4*)((const LAS float*)(lds + QKP_OFF) + rl * 8 + bj * 4);
                        const float rs = __builtin_amdgcn_rsqf(((p4[0] + p4[1]) + (p4[2] + p4[3])) * (1.f / 128.f) + EPS);
#pragma unroll
                        for (int i = 0; i < 4; ++i) { const float e0 = v[2 * i] * rs * gw[2 * i], o0 = v[2 * i + 1] * rs * gw[2 * i + 1];
                            v[2 * i] = e0 * cs[i] - o0 * sn[i]; v[2 * i + 1] = e0 * sn[i] + o0 * cs[i]; } }
                    u32x4 w; w.x = cvt_pk_bf16(v[0], v[1]); w.y = cvt_pk_bf16(v[2], v[3]); w.z = cvt_pk_bf16(v[4], v[5]); w.w = cvt_pk_bf16(v[6], v[7]);
                    bf16_t* dst = u.pn < 4 ? J.qn + row * 1024 + (2 * u.pn + bj) * 128 + cl : (u.pn == 4 ? J.kall : J.vall) + kvrow * 256 + bj * 128 + cl;
                    *(u32x4*)dst = w;
                }
                __builtin_amdgcn_sched_barrier(0);
            }
    } else if (J.mode == 2) {
        const int colg = u.pn * 128 + wc * 32 + 8 * fq, rowb = u.pm * BM + wr * 128 + fr * 8;
        const LAS float* cwl = (const LAS float*)(lds + CWL_OFF + upar * 2048) + wc * 32 + 8 * fq;
        f32x2 w0[4], w1[4], w2[4], bb[4];
#pragma unroll
        for (int h = 0; h < 2; ++h) { const f32x4 a = *(const LAS f32x4*)(cwl + 4 * h), b = *(const LAS f32x4*)(cwl + 128 + 4 * h), c = *(const LAS f32x4*)(cwl + 256 + 4 * h), d = *(const LAS f32x4*)(cwl + 384 + 4 * h);
            w0[2 * h] = (f32x2){a[0], a[1]}; w0[2 * h + 1] = (f32x2){a[2], a[3]}; w1[2 * h] = (f32x2){b[0], b[1]}; w1[2 * h + 1] = (f32x2){b[2], b[3]};
            w2[2 * h] = (f32x2){c[0], c[1]}; w2[2 * h + 1] = (f32x2){c[2], c[3]}; bb[2 * h] = (f32x2){d[0], d[1]}; bb[2 * h + 1] = (f32x2){d[2], d[3]}; }
#define GP2(j, q) ((f32x2){acc[(j) >> 2][0][(j) & 3][(q) >> 1][((q) & 1) * 2], acc[(j) >> 2][0][(j) & 3][(q) >> 1][((q) & 1) * 2 + 1]})
#define VP2(j, q) ((f32x2){acc[(j) >> 2][1][(j) & 3][(q) >> 1][((q) & 1) * 2], acc[(j) >> 2][1][(j) & 3][(q) >> 1][((q) & 1) * 2 + 1]})
        f32x2 gprev[4], gnext[4];
#pragma unroll
        for (int q = 0; q < 4; ++q) {
            const f32x2 last = GP2(7, q), first = GP2(0, q);
            gprev[q].x = __uint_as_float((unsigned)__builtin_amdgcn_update_dpp(0, (int)__float_as_uint(last.x), 0x111, 0xf, 0xf, false));
            gprev[q].y = __uint_as_float((unsigned)__builtin_amdgcn_update_dpp(0, (int)__float_as_uint(last.y), 0x111, 0xf, 0xf, false));
            gnext[q].x = __uint_as_float((unsigned)__builtin_amdgcn_update_dpp(0, (int)__float_as_uint(first.x), 0x101, 0xf, 0xf, false));
            gnext[q].y = __uint_as_float((unsigned)__builtin_amdgcn_update_dpp(0, (int)__float_as_uint(first.y), 0x101, 0xf, 0xf, false));
        }
        bf16_t* orow = J.O + (size_t)rowb * FFN + colg;
#pragma unroll
        for (int j = 0; j < 8; ++j) {
            f32x2 z[4]; unsigned ow[4];
#pragma unroll
            for (int q = 0; q < 4; ++q) {
                const f32x2 gp = j == 0 ? gprev[q] : GP2(j == 0 ? 0 : j - 1, q);
                const f32x2 gn = j == 7 ? gnext[q] : GP2(j == 7 ? 7 : j + 1, q);
                z[q] = gp * w0[q] + (GP2(j, q) * w1[q] + (gn * w2[q] + bb[q]));
                const f32x2 zz = z[q], t = zz * (zz * zz * 0.044715f + 1.0f), ex = t * (-2.302208198f);
                f32x2 d; d.x = __builtin_amdgcn_exp2f(ex.x); d.y = __builtin_amdgcn_exp2f(ex.y); d = d + 1.0f;
                f32x2 r; r.x = __builtin_amdgcn_rcpf(d.x); r.y = __builtin_amdgcn_rcpf(d.y);
                const f32x2 a = zz * r * VP2(j, q);
                ow[q] = cvt_pk_bf16(a.x, a.y);
            }
            u32x4 w; w.x = ow[0]; w.y = ow[1]; w.z = ow[2]; w.w = ow[3];
            *(u32x4*)(orow + (size_t)j * FFN) = w;
            if ((j == 0 && fr == 0) || (j == 7 && fr == 15)) {
                const size_t sb = (size_t)(u.pm * 4 + wr * 2 + (j == 7 ? 1 : 0)) * FFN + colg;
                *(f32x4*)(J.zp + sb) = (f32x4){z[0].x, z[0].y, z[1].x, z[1].y}; *(f32x4*)(J.zp + sb + 4) = (f32x4){z[2].x, z[2].y, z[3].x, z[3].y};
                *(f32x4*)(J.gv + sb) = acc[j >> 2][0][j & 3][0]; *(f32x4*)(J.gv + sb + 4) = acc[j >> 2][0][j & 3][1];
                *(f32x4*)(J.vv + sb) = acc[j >> 2][1][j & 3][0]; *(f32x4*)(J.vv + sb + 4) = acc[j >> 2][1][j & 3][1];
            }
        }
#undef GP2
#undef VP2
    } else {
        const bool lat = u.pn < 64;
        const int b = lat ? (u.pn >> 3) : (u.pn - 64), tbase = lat ? (u.pn & 7) * 256 : 0;
        const int ldy = lat ? SEQ : 2 * CTXL; const size_t halfoff = lat ? (size_t)1024 * SEQ : (size_t)CTXL;
        bf16_t* base = (lat ? J.O + (size_t)(b * 2048 + u.pm * 128) * ldy : J.O2 + (size_t)(b * 1024 + u.pm * 128) * ldy) + tbase + wc * 32 + 8 * fq;
#pragma unroll
        for (int ai = 0; ai < 2; ++ai)
#pragma unroll
            for (int m = 0; m < 4; ++m) { bf16_t* rowp = base + (size_t)(wr * 64 + m * 16 + fr) * ldy + ai * halfoff;
#pragma unroll
                for (int bj = 0; bj < 2; ++bj) { const f32x4 v0 = acc[ai][bj][m][0] * sc, v1 = acc[ai][bj][m][1] * sc;
                    u32x4 w; w.x = cvt_pk_bf16(v0[0], v0[1]); w.y = cvt_pk_bf16(v0[2], v0[3]); w.z = cvt_pk_bf16(v1[0], v1[1]); w.w = cvt_pk_bf16(v1[2], v1[3]);
                    *(u32x4*)(rowp + bj * HALF) = w; } }
    }
}

__device__ __forceinline__ void gemm_phase(LAS unsigned char* lds, const Job& g, const StaticOrder& S, const int tid) {
    const int wid = __builtin_amdgcn_readfirstlane(tid >> 6), lane = tid & 63, wr = wid >> 2, wc = wid & 3, fr = lane & 15, fq = lane >> 4;
    const int K = g.K, nt = K / BK;
    unsigned voffA[2], voffB[2];
#pragma unroll
    for (int i = 0; i < 2; ++i) { int R, C; stage_rc(tid * 16 + i * 8192, R, C); const int Rb = (R & ~31) + perm32(R & 31);
        const int Ra = g.mode == 2 ? ((R >> 6) * 128 + (R & 15) * 8 + ((R >> 4) & 3)) : R;
        voffA[i] = (unsigned)(Ra * g.lda + C) * 2u; voffB[i] = (unsigned)(Rb * g.ldb + C) * 2u; }
    const size_t kstep = (size_t)(BK * 2);
    const size_t hstepA = (size_t)(g.mode == 2 ? 4 : HALF) * g.lda * 2, hstepB = (size_t)HALF * g.ldb * 2;
    const unsigned ldsw = (unsigned)wid * 1024u;
    const int aoff = lds_byte(wr * 64 + fr, fq * 8), boff = lds_byte(wc * 32 + fr, fq * 8);
#define PG8_SA(b, h) (((b) * 2 + (h)) * HTB)
#define PG8_SB(b, h) ((4 + (b) * 2 + (h)) * HTB)
#define PG8_STAGE(bufoff, gbase, voff) do { _Pragma("unroll") for (int _i = 0; _i < 2; ++_i) \
        __builtin_amdgcn_global_load_lds((const unsigned*)((const char*)(gbase) + (voff)[_i]), (LAS unsigned*)(lds + (bufoff) + ldsw + _i * 8192), 16, 0, 0); } while (0)
#define PG8_LDA(dst, b, h) do { _Pragma("unroll") for (int m = 0; m < 4; ++m) _Pragma("unroll") for (int k = 0; k < 2; ++k) dst[m][k] = *(const LAS bf16x8*)(lds + PG8_SA(b, h) + aoff + m * 2048 + k * 1024); } while (0)
#define PG8_LDB(dst, b, h) do { _Pragma("unroll") for (int n = 0; n < 2; ++n) _Pragma("unroll") for (int k = 0; k < 2; ++k) dst[n][k] = *(const LAS bf16x8*)(lds + PG8_SB(b, h) + boff + n * 2048 + k * 1024); } while (0)
#define PG8_MMA(ai, bj, At, Bt) do { __builtin_amdgcn_s_setprio(1); _Pragma("unroll") for (int m = 0; m < 4; ++m) _Pragma("unroll") for (int n = 0; n < 2; ++n) _Pragma("unroll") for (int k = 0; k < 2; ++k) \
        acc[ai][bj][m][n] = __builtin_amdgcn_mfma_f32_16x16x32_bf16(Bt[n][k], At[m][k], acc[ai][bj][m][n], 0, 0, 0); __builtin_amdgcn_s_setprio(0); } while (0)
#define PG8_WAIT_V(n) asm volatile("s_waitcnt vmcnt(" #n ")" ::: "memory")
#define PG8_WAIT_L(n) asm volatile("s_waitcnt lgkmcnt(" #n ")" ::: "memory")
#define PG8_BAR __builtin_amdgcn_s_barrier()
#define PG8_SCHED __builtin_amdgcn_sched_barrier(0)
    Unit cur, nxt; int ui = 0;
#define PG8_FIXKS(u) do { if (g.ksplit > 1) { (u).ks = (u).pn / g.nN; (u).pn -= (u).ks * g.nN; } } while (0)
    if (!S.next(0, cur)) return;
    PG8_FIXKS(cur);
    f32x4 acc[2][2][4][2];
#pragma unroll
    for (int a = 0; a < 2; ++a)
#pragma unroll
        for (int b = 0; b < 2; ++b)
#pragma unroll
            for (int m = 0; m < 4; ++m)
#pragma unroll
                for (int n = 0; n < 2; ++n) acc[a][b][m][n] = (f32x4){0.f, 0.f, 0.f, 0.f};
    bf16x8 At[4][2], B0[2][2], B1[2][2];
    const char* cA = g.aptr(cur); const char* cB = g.bptr(cur);
    PG8_STAGE(PG8_SB(0, 0), cB, voffB); PG8_STAGE(PG8_SB(0, 1), cB + hstepB, voffB); PG8_STAGE(PG8_SA(0, 0), cA, voffA); PG8_STAGE(PG8_SA(0, 1), cA + hstepA, voffA);
    if (wr == 1) PG8_BAR;
    PG8_WAIT_V(2); PG8_BAR;
    PG8_STAGE(PG8_SB(1, 0), cB + kstep, voffB); PG8_STAGE(PG8_SA(1, 0), cA + kstep, voffA); PG8_STAGE(PG8_SB(1, 1), cB + hstepB + kstep, voffB);
    PG8_WAIT_V(6); PG8_BAR;
    for (;;) {
        const bool has_next = S.next(ui + 1, nxt);
        if (has_next) PG8_FIXKS(nxt);
        if (g.mode == 2) {
            const int arr = wid >> 1;
            const float* src = (arr < 3 ? g.cw + arr * FFN : g.cb) + cur.pn * 128 + (wid & 1) * 64 + lane;
            __builtin_amdgcn_global_load_lds((const unsigned*)src, (LAS unsigned*)(lds + CWL_OFF + (ui & 1) * 2048 + wid * 256), 4, 0, 0);
        }
        const char* nA = has_next ? g.aptr(nxt) : cA; const char* nB = has_next ? g.bptr(nxt) : cB;
        for (int t = 0; t < nt; t += 2) {
            const bool last = (t == nt - 2);
            const char* a1 = cA + (size_t)(t + 1) * kstep;
            const char* a2 = last ? nA : cA + (size_t)(t + 2) * kstep; const char* b2 = last ? nB : cB + (size_t)(t + 2) * kstep;
            const char* a3 = a2 + kstep; const char* b3 = b2 + kstep;
            PG8_LDB(B0, 0, 0); PG8_LDB(B1, 0, 1); PG8_SCHED; PG8_LDA(At, 0, 0); PG8_STAGE(PG8_SA(1, 1), a1 + hstepA, voffA);
            PG8_WAIT_V(8); PG8_WAIT_L(0); PG8_BAR; PG8_MMA(0, 0, At, B0); PG8_MMA(0, 1, At, B1); PG8_BAR; PG8_SCHED;
            PG8_LDA(At, 0, 1); PG8_STAGE(PG8_SB(0, 0), b2, voffB); PG8_STAGE(PG8_SB(0, 1), b2 + hstepB, voffB); PG8_STAGE(PG8_SA(0, 0), a2, voffA);
            PG8_WAIT_V(8); PG8_WAIT_L(0); PG8_BAR; PG8_MMA(1, 0, At, B0); PG8_MMA(1, 1, At, B1); PG8_BAR; PG8_SCHED;
            PG8_LDB(B0, 1, 0); PG8_LDB(B1, 1, 1); PG8_SCHED; PG8_LDA(At, 1, 0); PG8_STAGE(PG8_SA(0, 1), a2 + hstepA, voffA);
            PG8_WAIT_V(8); PG8_WAIT_L(0); PG8_BAR; PG8_MMA(0, 0, At, B0); PG8_MMA(0, 1, At, B1); PG8_BAR; PG8_SCHED;
            PG8_LDA(At, 1, 1); PG8_STAGE(PG8_SB(1, 0), b3, voffB); PG8_STAGE(PG8_SB(1, 1), b3 + hstepB, voffB); PG8_STAGE(PG8_SA(1, 0), a3, voffA);
            PG8_WAIT_V(8); PG8_WAIT_L(0); PG8_BAR; PG8_MMA(1, 0, At, B0); PG8_MMA(1, 1, At, B1); PG8_BAR; PG8_SCHED;
        }
        if (wr == 0) PG8_BAR;
        epilogue(g, acc, cur, wr, wc, fr, fq, lds, ui & 1);
        if (!has_next) break;
#pragma unroll
        for (int a = 0; a < 2; ++a)
#pragma unroll
            for (int b = 0; b < 2; ++b)
#pragma unroll
                for (int m = 0; m < 4; ++m)
#pragma unroll
                    for (int n = 0; n < 2; ++n) acc[a][b][m][n] = (f32x4){0.f, 0.f, 0.f, 0.f};
        cur = nxt; cA = nA; cB = nB; ++ui;
        if (wr == 1) PG8_BAR;
    }
    PG8_WAIT_V(0);
    PG8_BAR;
#undef PG8_FIXKS
#undef PG8_SA
#undef PG8_SB
#undef PG8_STAGE
#undef PG8_LDA
#undef PG8_LDB
#undef PG8_MMA
#undef PG8_WAIT_V
#undef PG8_WAIT_L
#undef PG8_BAR
#undef PG8_SCHED
}
}

namespace att {
using bf16 = __hip_bfloat16;
constexpr int D = 128, NW = 8, QBLK = 32, KVBLK = 64;
constexpr float SCALE = 0.088388347648318440f;
constexpr float THR = 8.f;
#ifndef ATT_SDEPTH
#define ATT_SDEPTH 2
#endif
constexpr int LDQ = 1024, LDK = 256, LDO = 1024;
constexpr size_t SHM_V = KVBLK * D * 2, SHM_K = KVBLK * D * 2, SHM_ATTN = 2 * SHM_V + 2 * SHM_K + NW * 64 * 4;
#define KSWZ(row, colB) ((row) * 256 + ((colB) ^ (((row) & 7) << 4)))
#define SBAR() __builtin_amdgcn_sched_barrier(0)
__device__ __forceinline__ int crow(int r, int hi) { return (r & 3) + 8 * (r >> 2) + 4 * hi; }
__device__ __forceinline__ unsigned cvtpk(float lo, float hi) { unsigned r; asm volatile("v_cvt_pk_bf16_f32 %0, %1, %2" : "=v"(r) : "v"(lo), "v"(hi)); return r; }
__device__ __forceinline__ bf16x8 ld8(const bf16* p) { return *reinterpret_cast<const bf16x8*>(p); }
__device__ __forceinline__ void partialSM(f32x16& p0, f32x16& p1, float& m_reg, float& mn, float& alpha) {
  constexpr float C = SCALE * 1.4426950408889634f;
  float pmax = p0[0]; for (int r = 1; r < 16; ++r) pmax = fmaxf(pmax, p0[r]); for (int r = 0; r < 16; ++r) pmax = fmaxf(pmax, p1[r]);
  { auto rr = __builtin_amdgcn_permlane32_swap(__float_as_uint(pmax), __float_as_uint(pmax), false, false);
    pmax = fmaxf(__uint_as_float(rr[0]), __uint_as_float(rr[1])); }
  if (__builtin_expect(__all(pmax - m_reg <= THR / SCALE), 1)) { mn = m_reg; alpha = 1.f; }
  else { mn = fmaxf(m_reg, pmax); alpha = __builtin_amdgcn_exp2f((m_reg - mn) * C); m_reg = mn; }
  float mnC = -mn * C;
  for (int r = 0; r < 16; ++r) p0[r] = fmaf(p0[r], C, mnC); for (int r = 0; r < 16; ++r) p1[r] = fmaf(p1[r], C, mnC);
  for (int r = 0; r < 16; ++r) p0[r] = __builtin_amdgcn_exp2f(p0[r]);
}
__device__ __forceinline__ void finishSM(f32x16& p0, f32x16& p1, float alpha, float& l_reg, bf16x8& pa0, bf16x8& pa1, bf16x8& pa2, bf16x8& pa3) {
  for (int r = 0; r < 16; ++r) p1[r] = __builtin_amdgcn_exp2f(p1[r]);
  float ps = 0; for (int r = 0; r < 16; ++r) ps += p0[r]; for (int r = 0; r < 16; ++r) ps += p1[r];
  { auto rr = __builtin_amdgcn_permlane32_swap(__float_as_uint(ps), __float_as_uint(ps), false, false);
    ps = __uint_as_float(rr[0]) + __uint_as_float(rr[1]); }
  l_reg = l_reg * alpha + ps;
#define PK4(P, BASE, OUT) do { unsigned a0 = cvtpk(P[BASE + 0], P[BASE + 1]), a1 = cvtpk(P[BASE + 2], P[BASE + 3]);   \
    unsigned b0 = cvtpk(P[BASE + 4], P[BASE + 5]), b1 = cvtpk(P[BASE + 6], P[BASE + 7]);                              \
    auto r0 = __builtin_amdgcn_permlane32_swap(a0, b0, false, false); auto r1 = __builtin_amdgcn_permlane32_swap(a1, b1, false, false); \
    u32x4 w = {r0[0], r1[0], r0[1], r1[1]}; OUT = *reinterpret_cast<bf16x8*>(&w); } while (0)
  PK4(p0, 0, pa0); PK4(p0, 8, pa1); PK4(p1, 0, pa2); PK4(p1, 8, pa3);
#undef PK4
}
__device__ __forceinline__ void qkt(f32x16& p0, f32x16& p1, const bf16* Ks, const bf16x8* qr, int r32, int hi) {
  p0 = f32x16{}; p1 = f32x16{};
  for (int d0 = 0; d0 < 8; ++d0) { int cb = (d0 * 16 + hi * 8) * 2;
    bf16x8 b0 = *reinterpret_cast<const bf16x8*>((const char*)Ks + KSWZ(r32, cb));
    bf16x8 b1 = *reinterpret_cast<const bf16x8*>((const char*)Ks + KSWZ(32 + r32, cb));
    p0 = __builtin_amdgcn_mfma_f32_32x32x16_bf16(b0, qr[d0], p0, 0, 0, 0);
    p1 = __builtin_amdgcn_mfma_f32_32x32x16_bf16(b1, qr[d0], p1, 0, 0, 0); }
}
__device__ __forceinline__ int v_st(int k, int c) { const int kk = (k & ~0xC) | ((k & 4) << 1) | ((k & 8) >> 1); return ((kk >> 3) * 4 + (c >> 5)) * 512 + ((kk & 7) * 32 + (c & 31)) * 2; }
__device__ __forceinline__ int v_rd_base(int lane) { return ((lane & 3) << 3) | (((lane >> 2) & 3) << 6) | (((lane >> 4) & 1) << 5) | (((lane >> 5) & 1) << 8); }
constexpr int v_rd_off(int d0, int ks, int half) { return d0 * 512 + ks * 4096 + half * 2048; }
template <int OFF> __device__ __forceinline__ s16x4 tr_read(int vb) {
  s16x4 r; asm volatile("ds_read_b64_tr_b16 %0, %1 offset:%2" : "=&v"(r) : "v"(vb), "i"(OFF) : "memory"); return r;
}
template <int D0> __device__ __forceinline__ void pv_one(f32x16& od, int vb, bf16x8 pa0, bf16x8 pa1, bf16x8 pa2, bf16x8 pa3) {
  const s16x4 l0 = tr_read<v_rd_off(D0, 0, 0)>(vb), h0 = tr_read<v_rd_off(D0, 0, 1)>(vb), l1 = tr_read<v_rd_off(D0, 1, 0)>(vb), h1 = tr_read<v_rd_off(D0, 1, 1)>(vb);
  const s16x4 l2 = tr_read<v_rd_off(D0, 2, 0)>(vb), h2 = tr_read<v_rd_off(D0, 2, 1)>(vb), l3 = tr_read<v_rd_off(D0, 3, 0)>(vb), h3 = tr_read<v_rd_off(D0, 3, 1)>(vb);
  asm volatile("s_waitcnt lgkmcnt(0)" ::: "memory"); SBAR();
#define PK(L, H) (bf16x8){L[0], L[1], L[2], L[3], H[0], H[1], H[2], H[3]}
  od = __builtin_amdgcn_mfma_f32_32x32x16_bf16(pa0, PK(l0, h0), od, 0, 0, 0);
  od = __builtin_amdgcn_mfma_f32_32x32x16_bf16(pa1, PK(l1, h1), od, 0, 0, 0);
  od = __builtin_amdgcn_mfma_f32_32x32x16_bf16(pa2, PK(l2, h2), od, 0, 0, 0);
  od = __builtin_amdgcn_mfma_f32_32x32x16_bf16(pa3, PK(l3, h3), od, 0, 0, 0);
#undef PK
}
__device__ __forceinline__ void pv_d0(f32x16* o, int vb, bf16x8 pa0, bf16x8 pa1, bf16x8 pa2, bf16x8 pa3) {
  pv_one<0>(o[0], vb, pa0, pa1, pa2, pa3); pv_one<1>(o[1], vb, pa0, pa1, pa2, pa3); pv_one<2>(o[2], vb, pa0, pa1, pa2, pa3); pv_one<3>(o[3], vb, pa0, pa1, pa2, pa3);
}
__device__ __forceinline__ void attn_dense_body(const bf16* __restrict__ Qb, const bf16* __restrict__ Kh, const bf16* __restrict__ Vh,
                                                bf16_t* __restrict__ Ob, int seq, char* lds, const int tid) {
  constexpr int SDEPTH = ATT_SDEPTH;
  const int wid = tid >> 6, lane = tid & 63, r32 = lane & 31, hi = lane >> 5;
  bf16* V_lds = (bf16*)lds; bf16* K_lds = (bf16*)(lds + 2 * SHM_V);
  float* ws = (float*)(lds + 2 * SHM_V + 2 * SHM_K) + wid * 64; float* li_l = ws; float* al_l = ws + 32;
  float m_reg = -1e30f, l_reg = 0; f32x16 o[4] = {}; bf16x8 qr[8];
  const bf16* Qw = Qb + (long)(wid * QBLK + r32) * LDQ + hi * 8;
#pragma unroll
  for (int d0 = 0; d0 < 8; ++d0) qr[d0] = ld8(Qw + d0 * 16);
  const int sr = tid >> 4, sc = (tid & 15) * 8, vst0 = v_st(sr, sc), vst1 = v_st(32 + sr, sc);
  const int vb0 = (int)(uintptr_t)V_lds + v_rd_base(lane);
  struct { bf16x8 vs0, vs1, ks0, ks1; } sr_[SDEPTH];
  const unsigned loff = (unsigned)(sr * LDK + sc) * 2u;
#define SLOAD(i, k0) do { const char* vb_ = (const char*)(Vh + (long)(k0) * LDK); const char* kb_ = (const char*)(Kh + (long)(k0) * LDK); \
    sr_[i].vs0 = *(const bf16x8*)(vb_ + loff); sr_[i].vs1 = *(const bf16x8*)(vb_ + 32 * LDK * 2 + loff); \
    sr_[i].ks0 = *(const bf16x8*)(kb_ + loff); sr_[i].ks1 = *(const bf16x8*)(kb_ + 32 * LDK * 2 + loff); } while (0)
#define SWRITE(b, i) do { *(bf16x8*)((char*)V_lds + (b) * SHM_V + vst0) = sr_[i].vs0;          \
    *(bf16x8*)((char*)V_lds + (b) * SHM_V + vst1) = sr_[i].vs1; int kc = sc * 2;               \
    *(bf16x8*)((char*)K_lds + (b) * SHM_K + KSWZ(sr, kc)) = sr_[i].ks0;                       \
    *(bf16x8*)((char*)K_lds + (b) * SHM_K + KSWZ(32 + sr, kc)) = sr_[i].ks1; } while (0)
#define SWAIT() do { if constexpr (SDEPTH == 2) asm volatile("s_waitcnt vmcnt(4)" ::: "memory"); else asm volatile("s_waitcnt vmcnt(0)" ::: "memory"); } while (0)
#define RESC(a) do { if (__any((a) < 1.f)) { if (hi == 0) al_l[r32] = (a); asm volatile("s_waitcnt lgkmcnt(0)" ::: "memory"); \
    for (int d = 0; d < 4; ++d) for (int r = 0; r < 16; ++r) o[d][r] *= al_l[crow(r, hi)]; } } while (0)
  f32x16 pA0, pA1, pB0, pB1; float mnA, mnB, alA, alB; bf16x8 pa0, pa1, pa2, pa3; const int NT = seq / KVBLK;
  constexpr int SE = 0, SO = SDEPTH - 1;
  SLOAD(SE, 0); asm volatile("s_waitcnt vmcnt(0)" ::: "memory"); SWRITE(0, SE); __syncthreads();
  qkt(pA0, pA1, K_lds, qr, r32, hi); partialSM(pA0, pA1, m_reg, mnA, alA);
  SLOAD(SO, KVBLK); if constexpr (SDEPTH == 2) { if (2 < NT) SLOAD(SE, 2 * KVBLK); }
  SWAIT(); SWRITE(1, SO); __syncthreads();
  for (int j = 1; j + 1 < NT; j += 2) {
    SBAR(); qkt(pB0, pB1, (bf16*)((char*)K_lds + SHM_K), qr, r32, hi);
    finishSM(pA0, pA1, alA, l_reg, pa0, pa1, pa2, pa3); SBAR();
    SLOAD(SO, (j + SDEPTH) * KVBLK); SBAR();
    pv_d0(o, vb0, pa0, pa1, pa2, pa3); partialSM(pB0, pB1, m_reg, mnB, alB);
    __syncthreads(); SWAIT(); SWRITE(0, SE);
    RESC(alB); __syncthreads();
    SBAR(); qkt(pA0, pA1, K_lds, qr, r32, hi);
    finishSM(pB0, pB1, alB, l_reg, pa0, pa1, pa2, pa3); SBAR();
    if (SDEPTH == 1 || j + 3 < NT) SLOAD(SE, (j + 1 + SDEPTH) * KVBLK); SBAR();
    pv_d0(o, vb0 + (int)SHM_V, pa0, pa1, pa2, pa3); partialSM(pA0, pA1, m_reg, mnA, alA);
    __syncthreads(); SWAIT(); SWRITE(1, SO);
    RESC(alA); __syncthreads();
  }
  SBAR(); qkt(pB0, pB1, (bf16*)((char*)K_lds + SHM_K), qr, r32, hi);
  finishSM(pA0, pA1, alA, l_reg, pa0, pa1, pa2, pa3); SBAR();
  pv_d0(o, vb0, pa0, pa1, pa2, pa3); partialSM(pB0, pB1, m_reg, mnB, alB);
  __syncthreads(); RESC(alB);
  finishSM(pB0, pB1, alB, l_reg, pa0, pa1, pa2, pa3); SBAR();
  pv_d0(o, vb0 + (int)SHM_V, pa0, pa1, pa2, pa3);
  if (hi == 0) li_l[r32] = l_reg; asm volatile("s_waitcnt lgkmcnt(0)" ::: "memory");
  float rli[16];
#pragma unroll
  for (int r = 0; r < 16; ++r) rli[r] = __builtin_amdgcn_rcpf(li_l[crow(r, hi)]);
  bf16_t* Ow = Ob + (long)(wid * QBLK) * LDO;
#pragma unroll
  for (int r = 0; r < 16; ++r) { int orow = crow(r, hi);
    for (int d0 = 0; d0 < 4; ++d0) Ow[(long)orow * LDO + d0 * 32 + r32] = (bf16_t)(cvtpk(o[d0][r] * rli[r], 0.f) & 0xffffu); }
#undef SLOAD
#undef SWRITE
#undef SWAIT
#undef RESC
}
#undef KSWZ
#undef SBAR
}

template <bool GLU> __device__ __forceinline__ void p0_transpose_item(const float* W, int K, int N, bf16_t* WT, LAS float* scr, int item, int lane) {
    const int nblk = N / 32, kb = item / nblk, nb = item % nblk, k0 = 64 * kb, n0 = 32 * nb;
    const int n0d = !GLU ? n0 : (n0 < FFN ? (n0 >> 7) * 256 + (n0 & 127) : ((n0 - FFN) >> 7) * 256 + 128 + ((n0 - FFN) & 127));
    float v[32];
    const float* wp0 = W + (size_t)(k0 + (lane >> 5)) * N + n0 + (lane & 31);
#pragma unroll
    for (int i = 0; i < 32; ++i) v[i] = wp0[(size_t)(2 * i) * N];
#pragma unroll
    for (int i = 0; i < 32; ++i) scr[(2 * i + (lane >> 5)) * 33 + (lane & 31)] = v[i];
    asm volatile("s_waitcnt lgkmcnt(0)" ::: "memory");
    const int c = lane & 7;
#pragma unroll
    for (int j = 0; j < 4; ++j) { const int n = (lane >> 3) + 8 * j; const LAS float* s = scr + (8 * c) * 33 + n;
        u32x4 o; o.x = cvt_pk_bf16(s[0 * 33], s[1 * 33]); o.y = cvt_pk_bf16(s[2 * 33], s[3 * 33]); o.z = cvt_pk_bf16(s[4 * 33], s[5 * 33]); o.w = cvt_pk_bf16(s[6 * 33], s[7 * 33]);
        *(u32x4*)(WT + (size_t)(n0d + n) * K + k0 + 8 * c) = o; }
    asm volatile("s_waitcnt lgkmcnt(0)" ::: "memory");
}

__device__ __forceinline__ void phase0(KP pp, LAS unsigned char* lds, int G, const int tid, const int bid) {
    const int lane = tid & 63, wave = tid >> 6;
    unsigned char* ws = pp->ws;
    LAS float* sv = (LAS float*)lds;
    for (int i = tid; i < 9 * DM; i += NTHREADS) { const int r = i / DM, k = i % DM; const float v = r < 8 ? pp->in[1][r * DM + k] : pp->in[3][k];
        sv[i] = v / (1.f + __expf(-v)); }
    __syncthreads();
    {
        const float* wmod = pp->in[4]; float* part = (float*)(ws + WS_MODP);
        LAS float* red = (LAS float*)(lds + 9 * DM * 4);
        const int grp = tid >> 7, t7 = tid & 127;
        for (int it = bid; it < 768; it += G) {
            const int L = it / 384, rem = it % 384, cb = rem % 24, kc = rem / 24;
            const int col = cb * 512 + t7 * 4, kb = kc * 128 + grp * 32;
            f32x4 acc[9];
#pragma unroll
            for (int r = 0; r < 9; ++r) acc[r] = (f32x4){0.f, 0.f, 0.f, 0.f};
            const float* wp = wmod + ((size_t)L * DM + kb) * NMODC + col;
#pragma unroll 8
            for (int k = 0; k < 32; ++k) { const f32x4 w = *(const f32x4*)(wp + (size_t)k * NMODC);
#pragma unroll
                for (int r = 0; r < 9; ++r) acc[r] += w * sv[r * DM + kb + k]; }
            if (grp > 0) {
#pragma unroll
                for (int r = 0; r < 9; ++r) *(LAS f32x4*)(red + ((grp - 1) * 9 + r) * 512 + t7 * 4) = acc[r];
            }
            __syncthreads();
            if (grp == 0) {
#pragma unroll
                for (int r = 0; r < 9; ++r) { f32x4 a = acc[r];
#pragma unroll
                    for (int g2 = 0; g2 < 3; ++g2) a += *(const LAS f32x4*)(red + (g2 * 9 + r) * 512 + t7 * 4);
                    *(f32x4*)(part + ((size_t)(kc * 2 + L) * 9 + r) * NMODC + col) = a; }
            }
            __syncthreads();
        }
    }
    __syncthreads();
    {
        LAS float* scr = (LAS float*)(lds + wave * 16384);
        const int gw = bid * NWAVES + wave, NGW = G * NWAVES;
        constexpr int I_IN = (DM / 64) * (INW / 32), I_OUT = (DM / 64) * (DM / 32), I_UP = (DM / 64) * (UPW / 32), I_DN = (FFN / 64) * (DM / 32);
        constexpr int PER = I_IN + I_OUT + I_UP + I_DN;
        for (int it = gw; it < 2 * PER; it += NGW) {
            const int L = it / PER; int r = it % PER;
            if (r < I_IN) { p0_transpose_item<false>(pp->in[10] + (size_t)L * DM * INW, DM, INW, (bf16_t*)(ws + WS_WIN) + (size_t)L * INW * DM, scr, r, lane); continue; } r -= I_IN;
            if (r < I_OUT) { p0_transpose_item<false>(pp->in[16] + (size_t)L * DM * DM, DM, DM, (bf16_t*)(ws + WS_WOUT) + (size_t)L * DM * DM, scr, r, lane); continue; } r -= I_OUT;
            if (r < I_UP) { p0_transpose_item<true>(pp->in[17] + (size_t)L * DM * UPW, DM, UPW, (bf16_t*)(ws + WS_WUP) + (size_t)L * UPW * DM, scr, r, lane); continue; } r -= I_UP;
            p0_transpose_item<false>(pp->in[20] + (size_t)L * FFN * DM, FFN, DM, (bf16_t*)(ws + WS_WDN) + (size_t)L * DM * FFN, scr, r, lane);
        }
    }
    __syncthreads();
    {
        const int gt = bid * NTHREADS + tid, NGT = G * NTHREADS;
        bf16_t* d2048 = (bf16_t*)(ws + WS_D2048);
        for (int it = gt; it < 2048 * 2048 / 8; it += NGT) {
            const int r = it / 256, t0 = (it % 256) * 8, k = r & 1023; float v[8];
#pragma unroll
            for (int e = 0; e < 8; ++e) { const float rev = (float)((k * (t0 + e)) & 2047) * (1.f / 2048.f);
                v[e] = r < 1024 ? __builtin_amdgcn_cosf(rev) : __builtin_amdgcn_sinf(rev); }
            u32x4 o; o.x = cvt_pk_bf16(v[0], v[1]); o.y = cvt_pk_bf16(v[2], v[3]); o.z = cvt_pk_bf16(v[4], v[5]); o.w = cvt_pk_bf16(v[6], v[7]);
            *(u32x4*)(d2048 + (size_t)r * 2048 + t0) = o;
        }
        bf16_t* d256 = (bf16_t*)(ws + WS_D256);
        for (int it = gt; it < 256 * 512 / 8; it += NGT) {
            const int k = it / 64, tt0 = (it % 64) * 8; float v[8];
#pragma unroll
            for (int e = 0; e < 8; ++e) { const int tt = tt0 + e, t = tt & 255; const float rev = (float)((k * t) & 255) * (1.f / 256.f);
                v[e] = tt < 256 ? __builtin_amdgcn_cosf(rev) : -__builtin_amdgcn_sinf(rev); }
            u32x4 o; o.x = cvt_pk_bf16(v[0], v[1]); o.y = cvt_pk_bf16(v[2], v[3]); o.z = cvt_pk_bf16(v[4], v[5]); o.w = cvt_pk_bf16(v[6], v[7]);
            *(u32x4*)(d256 + (size_t)k * 512 + tt0) = o;
        }
        LAS float* tab = (LAS float*)lds;
        LAS float* wl = (LAS float*)lds + 256;
        const float* wf = pp->in[13]; bf16_t* cws = (bf16_t*)(ws + WS_CWS);
        for (int it = bid; it < 256; it += G) {
            const int lg = it >> 4, half = (it >> 3) & 1, cblk = it & 7;
            __syncthreads();
            if (tid < 128) { const float rev = (float)tid * (1.f / 128.f); tab[tid] = __builtin_amdgcn_cosf(rev); tab[128 + tid] = __builtin_amdgcn_sinf(rev); }
#pragma unroll
            for (int i = 0; i < 8; ++i) *(LAS f32x4*)(wl + (i * 512 + tid) * 4) = *(const f32x4*)(wf + (size_t)lg * 16384 + (i * 512 + tid) * 4);
            __syncthreads();
            const int d = tid & 127, c0 = cblk * 16 + (tid >> 7) * 4;
            const LAS float* tb = tab + half * 128;
            float s0 = 0.f, s1 = 0.f, s2 = 0.f, s3 = 0.f;
#pragma unroll 8
            for (int l = 0; l < 128; ++l) { const float w = wl[l * 128 + d];
                s0 += tb[(l * c0) & 127] * w; s1 += tb[(l * (c0 + 1)) & 127] * w; s2 += tb[(l * (c0 + 2)) & 127] * w; s3 += tb[(l * (c0 + 3)) & 127] * w; }
            u32x2 o; o.x = cvt_pk_bf16(s0, s1); o.y = cvt_pk_bf16(s2, s3);
            *(u32x2*)(cws + ((size_t)lg * 256 + half * 128 + d) * 128 + c0) = o;
        }
    }
}

__device__ __forceinline__ void phase0b(KP pp, int G, const int tid, const int bid) {
    const int gt = bid * NTHREADS + tid, NGT = G * NTHREADS;
    const float* part = (const float*)(pp->ws + WS_MODP); float* mod = (float*)(pp->ws + WS_MOD); const float* bmod = pp->in[5];
    for (int i = gt; i < 2 * 9 * NMODC; i += NGT) {
        const int col = i % NMODC, L = i / (9 * NMODC);
        float s = bmod[L * NMODC + col];
#pragma unroll
        for (int kc = 0; kc < 16; ++kc) s += part[(size_t)kc * 2 * 9 * NMODC + i];
        mod[i] = s;
    }
}

struct RM {
    int nrows;
    const float* srcL; const float* srcC; const bf16_t* srcB; float* dstF; bf16_t* dstB;
    const bf16_t* y; const bf16_t* ysplit; const float* gate; const float* gpost;
    bf16_t* H; const float* gpre; const float* shift; const float* scale;
};
__device__ __forceinline__ void resid_mod(const RM& a, int G, const int tid, const int bid) {
    const int lane = tid & 63, gw = bid * NWAVES + (tid >> 6), NGW = G * NWAVES;
    for (int row = gw; row < a.nrows; row += NGW) {
        const bool lat = row < ML; const int mr = lat ? row / SEQ : 8;
        f32x4 x[8];
        if (a.srcB) {
            u32x2 w[8];
#pragma unroll
            for (int j = 0; j < 8; ++j) w[j] = *(const u32x2*)(a.srcB + (size_t)row * DM + j * 256 + lane * 4);
#pragma unroll
            for (int j = 0; j < 8; ++j) x[j] = (f32x4){bf_lo(w[j].x), bf_hi(w[j].x), bf_lo(w[j].y), bf_hi(w[j].y)};
        } else {
            const float* src = lat ? a.srcL + (size_t)row * DM : a.srcC + (size_t)(row - ML) * DM;
#pragma unroll
            for (int j = 0; j < 8; ++j) x[j] = *(const f32x4*)(src + j * 256 + lane * 4);
        }
        if (a.y) {
            const bf16_t* yr = a.y + (size_t)row * DM; f32x4 yv[8]; float ss = 0.f;
            if (lat || !a.ysplit) {
                u32x2 w[8];
#pragma unroll
                for (int j = 0; j < 8; ++j) w[j] = *(const u32x2*)(yr + j * 256 + lane * 4);
#pragma unroll
                for (int j = 0; j < 8; ++j) yv[j] = (f32x4){bf_lo(w[j].x), bf_hi(w[j].x), bf_lo(w[j].y), bf_hi(w[j].y)};
            } else {
#pragma unroll
                for (int j = 0; j < 8; ++j) yv[j] = (f32x4){0.f, 0.f, 0.f, 0.f};
#pragma unroll
                for (int ks = 0; ks < 4; ++ks) {
                    u32x2 w[8];
#pragma unroll
                    for (int j = 0; j < 8; ++j) w[j] = *(const u32x2*)(a.ysplit + ((size_t)ks * MC + (row - ML)) * DM + j * 256 + lane * 4);
#pragma unroll
                    for (int j = 0; j < 8; ++j) yv[j] += (f32x4){bf_lo(w[j].x), bf_hi(w[j].x), bf_lo(w[j].y), bf_hi(w[j].y)};
                }
            }
#pragma unroll
            for (int j = 0; j < 8; ++j) ss += (yv[j].x * yv[j].x + yv[j].y * yv[j].y) + (yv[j].z * yv[j].z + yv[j].w * yv[j].w);
            const float rstd = __builtin_amdgcn_rsqf(wave_sum(ss) * (1.f / DM) + EPS);
            const float* gt = a.gate + (size_t)mr * NMODC;
#pragma unroll
            for (int j = 0; j < 8; ++j) { const int e = j * 256 + lane * 4; const f32x4 g = *(const f32x4*)(gt + e), gp = *(const f32x4*)(a.gpost + e);
                x[j] = x[j] + g * (yv[j] * rstd * gp);
                if (a.dstB) { u32x2 w; w.x = cvt_pk_bf16(x[j].x, x[j].y); w.y = cvt_pk_bf16(x[j].z, x[j].w); *(u32x2*)(a.dstB + (size_t)row * DM + e) = w;
                    x[j] = (f32x4){bf_lo(w.x), bf_hi(w.x), bf_lo(w.y), bf_hi(w.y)}; }
                else *(f32x4*)(a.dstF + (size_t)row * DM + e) = x[j]; }
        }
        if (a.H) {
            float ss = 0.f;
#pragma unroll
            for (int j = 0; j < 8; ++j) ss += (x[j].x * x[j].x + x[j].y * x[j].y) + (x[j].z * x[j].z + x[j].w * x[j].w);
            const float rstd = __builtin_amdgcn_rsqf(wave_sum(ss) * (1.f / DM) + EPS);
            const float* sh = a.shift + (size_t)mr * NMODC; const float* scl = a.scale + (size_t)mr * NMODC; bf16_t* hr = a.H + (size_t)row * DM;
#pragma unroll
            for (int j = 0; j < 8; ++j) { const int e = j * 256 + lane * 4; const f32x4 g = *(const f32x4*)(a.gpre + e), s1 = *(const f32x4*)(scl + e), s0 = *(const f32x4*)(sh + e);
                const f32x4 h = (x[j] * rstd * g) * (s1 + 1.f) + s0; u32x2 w; w.x = cvt_pk_bf16(h.x, h.y); w.y = cvt_pk_bf16(h.z, h.w);
                *(u32x2*)(hr + e) = w; }
        }
    }
}

__device__ __forceinline__ void merge_phase(const bf16_t* attO, const bf16_t* fourO, const float* nyq, const float* gattn, const float* gfour, bf16_t* Y, int nrows, int G, const int tid, const int bid) {
    const int lane = tid & 63, gw = bid * NWAVES + (tid >> 6), NGW = G * NWAVES;
    for (int row = gw; row < nrows; row += NGW) {
        f32x4 a[4], f[4]; float sa = 0.f, sf = 0.f;
#pragma unroll
        for (int j = 0; j < 4; ++j) { const u32x2 w = *(const u32x2*)(attO + (size_t)row * 1024 + j * 256 + lane * 4); a[j] = (f32x4){bf_lo(w.x), bf_hi(w.x), bf_lo(w.y), bf_hi(w.y)}; }
        if (row < ML) {
            const int b = row >> 11, k = row & 2047, kk = k <= 1024 ? k : 2048 - k; const float sg = k <= 1024 ? -1.f : 1.f;
            const bool hasS = (kk != 0 && kk != 1024);
            const bf16_t* crow = fourO + ((size_t)b * 2048 + (kk < 1024 ? kk : 0)) * 1024; const bf16_t* srow = fourO + ((size_t)b * 2048 + 1024 + (hasS ? kk : 0)) * 1024;
            u32x2 wc[4], wsn[4];
#pragma unroll
            for (int j = 0; j < 4; ++j) { wc[j] = *(const u32x2*)(crow + j * 256 + lane * 4); wsn[j] = *(const u32x2*)(srow + j * 256 + lane * 4); }
#pragma unroll
            for (int j = 0; j < 4; ++j) { f32x4 c = (f32x4){bf_lo(wc[j].x), bf_hi(wc[j].x), bf_lo(wc[j].y), bf_hi(wc[j].y)};
                if (kk == 1024) c = *(const f32x4*)(nyq + b * 1024 + j * 256 + lane * 4);
                const f32x4 sv = (f32x4){bf_lo(wsn[j].x), bf_hi(wsn[j].x), bf_lo(wsn[j].y), bf_hi(wsn[j].y)};
                f[j] = hasS ? c + sv * sg : c; }
        } else {
#pragma unroll
            for (int j = 0; j < 4; ++j) { const u32x2 w = *(const u32x2*)(fourO + (size_t)row * 1024 + j * 256 + lane * 4); f[j] = (f32x4){bf_lo(w.x), bf_hi(w.x), bf_lo(w.y), bf_hi(w.y)}; }
        }
#pragma unroll
        for (int j = 0; j < 4; ++j) {
            sa += (a[j].x * a[j].x + a[j].y * a[j].y) + (a[j].z * a[j].z + a[j].w * a[j].w);
            sf += (f[j].x * f[j].x + f[j].y * f[j].y) + (f[j].z * f[j].z + f[j].w * f[j].w); }
        const float ra = __builtin_amdgcn_rsqf(wave_sum(sa) * (1.f / 1024.f) + EPS), rf = __builtin_amdgcn_rsqf(wave_sum(sf) * (1.f / 1024.f) + EPS);
        bf16_t* yr = Y + (size_t)row * DM;
#pragma unroll
        for (int j = 0; j < 4; ++j) { const int e = j * 256 + lane * 4; const f32x4 ga = *(const f32x4*)(gattn + e), gf = *(const f32x4*)(gfour + e);
            const f32x4 va = a[j] * ra * ga, vf = f[j] * rf * gf; u32x2 w; w.x = cvt_pk_bf16(va.x, va.y); w.y = cvt_pk_bf16(va.z, va.w); *(u32x2*)(yr + e) = w;
            w.x = cvt_pk_bf16(vf.x, vf.y); w.y = cvt_pk_bf16(vf.z, vf.w); *(u32x2*)(yr + 1024 + e) = w; }
    }
}

__device__ __forceinline__ void nyq_phase(const bf16_t* YTL, float* nyq, int G, const int tid, const int bid) {
    const int lane = tid & 63, gw = bid * NWAVES + (tid >> 6), NGW = G * NWAVES;
    for (int idx = gw; idx < NB * 1024; idx += NGW) {
        const int b = idx >> 10, ch = idx & 1023;
        const bf16_t* r = YTL + ((size_t)(b * 2) * 1024 + ch) * SEQ + lane * 8;
        float s = 0.f;
#pragma unroll
        for (int i = 0; i < 4; ++i) { const u32x4 w = *(const u32x4*)(r + i * 512);
            s += (bf_lo(w.x) - bf_hi(w.x)) + (bf_lo(w.y) - bf_hi(w.y)) + (bf_lo(w.z) - bf_hi(w.z)) + (bf_lo(w.w) - bf_hi(w.w)); }
        s = wave_sum(s);
        if (lane == 0) nyq[idx] = s * (1.f / 512.f);
    }
}

__device__ __forceinline__ void glufix_phase(bf16_t* Aact, const float* zp, const float* gv, const float* vv, const float* cw, int nrows, int G, const int tid, const int bid) {
    const int gt = bid * NTHREADS + tid, NGT = G * NTHREADS;
    constexpr int NC4 = FFN / 4;
    const int nitems = (nrows / 256) * 4 * NC4;
    for (int it = gt; it < nitems; it += NGT) {
        const int brow = it / NC4, col = (it % NC4) * 4, k = brow & 3, pm = brow >> 2;
        const int r = pm * 256 + (k == 0 ? 0 : k == 1 ? 127 : k == 2 ? 128 : 255);
        const int slen = r < ML ? SEQ : CTXL;
        f32x4 miss = (f32x4){0.f, 0.f, 0.f, 0.f}; const float* wsel = cw + ((k & 1) ? 2 * FFN : 0) + col;
        if (k == 0) { if ((r % slen) != 0) miss = *(const f32x4*)(gv + (size_t)(brow - 1) * FFN + col); }
        else if (k == 3) { if (((r + 1) % slen) != 0) miss = *(const f32x4*)(gv + (size_t)(brow + 1) * FFN + col); }
        else miss = *(const f32x4*)(gv + (size_t)(k == 1 ? brow + 1 : brow - 1) * FFN + col);
        const f32x4 z = *(const f32x4*)(zp + (size_t)brow * FFN + col) + miss * *(const f32x4*)wsel, v = *(const f32x4*)(vv + (size_t)brow * FFN + col);
        u32x2 w; w.x = cvt_pk_bf16(gelu_tanh(z.x) * v.x, gelu_tanh(z.y) * v.y); w.y = cvt_pk_bf16(gelu_tanh(z.z) * v.z, gelu_tanh(z.w) * v.w);
        *(u32x2*)(Aact + (size_t)r * FFN + col) = w;
    }
}

#define XB_TMO      128
#define XB_XCNT(j)  (256  + 64 * (j))
#define XB_XSUB(j)  (1280 + 64 * (j))
#define XB_XGEN(j)  (2304 + 64 * (j))
#define XB_TOP      3328
#define XB_TOPGEN   3392
#define XCD_BAR_WORDS 3456
#define XB_SPIN_CAP (1u << 18)
__device__ __forceinline__ unsigned xb_ld(unsigned* p)              { return __hip_atomic_load(p, __ATOMIC_RELAXED, __HIP_MEMORY_SCOPE_AGENT); }
__device__ __forceinline__ unsigned xb_add(unsigned* p, unsigned v) { return __hip_atomic_fetch_add(p, v, __ATOMIC_RELAXED, __HIP_MEMORY_SCOPE_AGENT); }
__device__ __forceinline__ unsigned xb_xcc_id() { return (unsigned)__builtin_amdgcn_s_getreg((3 << 11) | 20) & 0xFu; }
#define XB_SPIN(cond, bar) do { unsigned _sp = 0; while (cond) { __builtin_amdgcn_s_sleep(1); \
    if ((++_sp & 255u) == 0u) { if (xb_ld(&(bar)[XB_TMO])) break; if (_sp > XB_SPIN_CAP) { atomicAdd(&(bar)[XB_TMO], 1u); break; } } } } while (0)
struct XcdBarrier { unsigned* bar; unsigned x; volatile LAS unsigned* st; };
__device__ __forceinline__ void xcd_barrier_complete(unsigned* bar, unsigned x, unsigned& nloc, unsigned& nx) {
    const unsigned G = gridDim.x * gridDim.y * gridDim.z;
    unsigned sum, cnt, mine, sp = 0u;
    for (;;) {
        sum = 0u; cnt = 0u; mine = 0u;
#pragma unroll
        for (unsigned j = 0; j < 16; ++j) { const unsigned c = xb_ld(&bar[XB_XCNT(j)]); sum += c; cnt += (c > 0u) ? 1u : 0u; mine = (j == x) ? c : mine; }
        if (sum == G) break;
        __builtin_amdgcn_s_sleep(1);
        if ((++sp & 255u) == 0u) { if (xb_ld(&bar[XB_TMO])) break; if (sp > XB_SPIN_CAP) { atomicAdd(&bar[XB_TMO], 1u); break; } }
    }
    nloc = mine > 0u ? mine : 1u; nx = cnt > 0u ? cnt : 1u;
}
__device__ __forceinline__ void xcd_barrier(const XcdBarrier& b, const int tid) {
    asm volatile("s_waitcnt vmcnt(0)" ::: "memory");
    __syncthreads();
    if (tid == 0) {
        unsigned* bar = b.bar;
        __builtin_amdgcn_s_waitcnt(0);
        unsigned nloc = b.st[0], nx = b.st[1];
        if (nloc == 0u) { xcd_barrier_complete(bar, b.x, nloc, nx); b.st[0] = nloc; b.st[1] = nx; }
        const unsigned old = xb_add(&bar[XB_XSUB(b.x)], 1u);
        const unsigned gen = old / nloc;
        if (old + 1u == (gen + 1u) * nloc) {
            __builtin_amdgcn_fence(__ATOMIC_RELEASE, "agent");
            asm volatile("s_waitcnt vmcnt(0)" ::: "memory");
            const unsigned og = xb_add(&bar[XB_TOP], 1u);
            const unsigned tg = og / nx;
            if (og + 1u == (tg + 1u) * nx) xb_add(&bar[XB_TOPGEN], 1u);
            else XB_SPIN(xb_ld(&bar[XB_TOPGEN]) == tg, bar);
            __builtin_amdgcn_fence(__ATOMIC_ACQUIRE, "agent");
            xb_add(&bar[XB_XGEN(b.x)], 1u);
            asm volatile("s_waitcnt vmcnt(0)" ::: "memory");
        } else {
            XB_SPIN(xb_ld(&bar[XB_XGEN(b.x)]) == gen, bar);
            __builtin_amdgcn_fence(__ATOMIC_ACQUIRE, "agent");
            asm volatile("s_waitcnt vmcnt(0)" ::: "memory");
        }
    }
    __syncthreads();
}

enum { ST_P0 = 0, ST_P0B, ST_RM0, ST_G1, ST_QK, ST_ATT, ST_MRG, ST_G2, ST_RM1, ST_G3, ST_CGLU, ST_G4, ST_RM2 };

__global__ void __launch_bounds__(NTHREADS, 2) fwd_megakernel(Params p_arg) {
    (void)p_arg;
    extern __shared__ __attribute__((aligned(16))) unsigned char lds_raw[];
    cg::grid_group grid = cg::this_grid();
    const int G = gridDim.x;
    const int wv_u = __builtin_amdgcn_readfirstlane((int)(threadIdx.x >> 6));
    {
        volatile LAS unsigned* st0 = (volatile LAS unsigned*)((LAS unsigned char*)lds_raw + 131072);
        if (threadIdx.x < 2) st0[threadIdx.x] = 0u;
        __syncthreads();
        if (threadIdx.x == 0) { KP pp0 = (KP)__builtin_amdgcn_kernarg_segment_ptr(); (void)xb_add((unsigned*)pp0->ws + XB_XCNT(xb_xcc_id()), 1u); }
    }

    constexpr int NSTEPS = 3 + 10 * DEPTH;
#pragma unroll 1
    for (int step = 0; step < NSTEPS; ++step) {
        unsigned zv; asm volatile("v_mov_b32 %0, 0" : "=v"(zv));
        const int tid = wv_u * 64 + (int)__builtin_amdgcn_mbcnt_hi(~0u, __builtin_amdgcn_mbcnt_lo(~0u, zv));
        int bid = blockIdx.x; asm volatile("" : "+s"(bid));
        KP pp = (KP)__builtin_amdgcn_kernarg_segment_ptr(); asm volatile("" : "+s"(pp));
        unsigned char* ws = pp->ws;
        LAS unsigned char* lds = (LAS unsigned char*)lds_raw;
        float* mod = (float*)(ws + WS_MOD);
        bf16_t* Hb = (bf16_t*)(ws + WS_H); bf16_t* MIX = (bf16_t*)(ws + WS_MIX); bf16_t* U = (bf16_t*)(ws + WS_R1);
        bf16_t* Pb = (bf16_t*)(ws + WS_P); bf16_t* Qn = (bf16_t*)(ws + WS_QN); bf16_t* Kall = (bf16_t*)(ws + WS_KALL); bf16_t* Vall = (bf16_t*)(ws + WS_VALL);
        bf16_t* YTL = (bf16_t*)(ws + WS_YTL); bf16_t* YTC = (bf16_t*)(ws + WS_YTC); bf16_t* attO = (bf16_t*)(ws + WS_ATTO); bf16_t* fourO = (bf16_t*)(ws + WS_FOURO);
        bf16_t* XS = (bf16_t*)(ws + WS_XS); bf16_t* YPART = (bf16_t*)(ws + WS_YPART);
        const int kind = step < 3 ? step : 3 + (step - 3) % 10;
        const int L = step < 3 ? 0 : (step - 3) / 10;
        const bool lastL = (L == DEPTH - 1);
        const int mrows = lastL ? ML : MT;
        const float* modL = mod + (size_t)L * 9 * NMODC;
        if (kind == ST_RM2 && lastL) continue;
        int njobs = 0;
        if (kind == ST_P0) phase0(pp, lds, G, tid, bid);
        else if (kind == ST_P0B) phase0b(pp, G, tid, bid);
        else if (kind == ST_RM0 || kind == ST_RM1 || kind == ST_RM2) {
            RM a;
            a.srcL = pp->in[0]; a.srcC = pp->in[2]; a.srcB = nullptr; a.dstF = nullptr; a.dstB = nullptr; a.y = nullptr; a.ysplit = nullptr; a.gate = nullptr; a.gpost = nullptr;
            if (kind == ST_RM0) { a.nrows = MT; a.H = Hb; a.gpre = pp->in[6]; a.shift = mod; a.scale = mod + DM; }
            else if (kind == ST_RM1) { a.nrows = mrows; a.srcB = L == 0 ? nullptr : XS; a.dstB = XS; a.y = MIX; a.ysplit = lastL ? nullptr : YPART; a.gate = modL + 2 * DM; a.gpost = pp->in[7] + L * DM;
                a.H = Hb; a.gpre = pp->in[8] + L * DM; a.shift = modL + 3 * DM; a.scale = modL + 4 * DM; }
            else { a.nrows = mrows; a.srcB = XS; a.dstB = lastL ? nullptr : XS; a.dstF = pp->out; a.y = MIX; a.ysplit = lastL ? nullptr : YPART; a.gate = modL + 5 * DM; a.gpost = pp->in[9] + L * DM;
                a.H = lastL ? nullptr : Hb; a.gpre = pp->in[6] + (L + 1) * DM; a.shift = modL + 9 * NMODC; a.scale = modL + 9 * NMODC + DM; }
            resid_mod(a, G, tid, bid);
        }
        else if (kind == ST_QK) { njobs = 1; }
        else if (kind == ST_MRG) merge_phase(attO, fourO, (const float*)(ws + WS_NYQ), pp->in[14] + L * 1024, pp->in[15] + L * 1024, Hb, mrows, G, tid, bid);
        else if (kind == ST_CGLU) glufix_phase(U, (const float*)(ws + WS_ZP), (const float*)(ws + WS_GV), (const float*)(ws + WS_VV), pp->in[18] + (size_t)L * 3 * FFN, mrows, G, tid, bid);
        else if (kind == ST_ATT) {
            const int nunits = lastL ? 512 : 576;
            for (int u = bid; u < nunits; u += G) {
                const att::bf16 *Qb, *Kh, *Vh; bf16_t* Ob; int seq;
                if (u < 512) {
                    int pair, j;
                    if (G == 256) { const int i = u >> 8, cc = u & 255; pair = i * 8 + (cc & 7); j = cc >> 3; } else { pair = u >> 5; j = u & 31; }
                    const int b = pair >> 1, kvh = pair & 1, gq = j >> 3, qb = j & 7, h = kvh * 4 + gq;
                    const size_t qrow = (size_t)b * SEQ + qb * 256;
                    Qb = (const att::bf16*)(Qn + qrow * 1024 + h * 128); Ob = attO + qrow * 1024 + h * 128;
                    Kh = (const att::bf16*)(Kall + (size_t)b * SKV * 256 + kvh * 128); Vh = (const att::bf16*)(Vall + (size_t)b * SKV * 256 + kvh * 128); seq = SKV;
                } else {
                    const int v = u - 512, b = v >> 3, h = v & 7;
                    const size_t qrow = (size_t)ML + b * CTXL;
                    Qb = (const att::bf16*)(Qn + qrow * 1024 + h * 128); Ob = attO + qrow * 1024 + h * 128;
                    Kh = (const att::bf16*)(Kall + ((size_t)b * SKV + SEQ) * 256 + (h >> 2) * 128); Vh = (const att::bf16*)(Vall + ((size_t)b * SKV + SEQ) * 256 + (h >> 2) * 128); seq = CTXL;
                }
                att::attn_dense_body(Qb, Kh, Vh, Ob, seq, (char*)lds_raw, tid);
                __syncthreads();
            }
            nyq_phase(YTL, (float*)(ws + WS_NYQ), G, tid, bid);
            njobs = lastL ? 1 : 2;
        }
        else njobs = ((kind == ST_G2 || kind == ST_G4) && !lastL) ? 2 : 1;

        for (int j = 0; j < njobs; ++j) {
            pg8::Job J; J.ksplit = 1; J.ostride_ks = 0; J.amod = 1 << 30; J.bdiv = 1 << 30; J.bstride_m = 0; J.mode = 0; J.scale = 1.f; J.O2 = nullptr; J.cw = nullptr; J.cb = nullptr; J.zp = nullptr; J.gv = nullptr; J.vv = nullptr; J.qn = nullptr; J.kall = nullptr; J.vall = nullptr; J.xs = nullptr; J.outf = nullptr; J.gate = nullptr; J.gpost = nullptr; J.xbuf = nullptr; J.pcnt = nullptr;
            if (kind == ST_G1) { J.A = Hb; J.lda = DM; J.B = (const bf16_t*)(ws + WS_WIN) + (size_t)L * INW * DM; J.ldb = DM; J.K = DM; J.nM = MT / 256; J.nN = INW / 256; J.O = Pb; J.ldc = INW; J.mode = 3; J.qn = Qn; J.kall = Kall; J.vall = Vall; }
            else if (kind == ST_QK) { J.A = (const bf16_t*)(ws + WS_CWS) + (size_t)L * 8 * 256 * 128; J.lda = 128; J.B = Pb + QKVW; J.ldb = INW; J.K = 128; J.nM = 8; J.nN = mrows / 256;
                J.bdiv = 1; J.bstride_m = 128; J.O = YTL; J.O2 = YTC; J.ldc = 0; J.mode = 1; }
            else if (kind == ST_ATT) {
                if (j == 0) { J.A = (const bf16_t*)(ws + WS_D2048); J.lda = 2048; J.amod = 8; J.B = YTL; J.ldb = 2048; J.bdiv = 4; J.bstride_m = (long)1024 * 2048; J.K = 2048; J.nM = 64; J.nN = 4;
                    J.O = fourO; J.ldc = 1024; J.scale = 1.f / 512.f; }
                else { J.A = (const bf16_t*)(ws + WS_D256); J.lda = 512; J.amod = 1; J.B = YTC; J.ldb = 512; J.bdiv = 1; J.bstride_m = (long)1024 * 512; J.K = 512; J.nM = 8; J.nN = 4;
                    J.O = fourO + (size_t)ML * 1024; J.ldc = 1024; J.scale = 0.005524271728019903f; }
            }
            else if (kind == ST_G2) { J.A = Hb; J.lda = DM; J.B = (const bf16_t*)(ws + WS_WOUT) + (size_t)L * DM * DM; J.ldb = DM; J.K = DM; J.nM = ML / 256; J.nN = DM / 256; J.O = MIX; J.ldc = DM;
                if (j == 1) { J.A = Hb + (size_t)ML * DM; J.nM = MC / 256; J.ksplit = 4; J.K = DM / 4; J.O = YPART; J.ostride_ks = (long)MC * DM; } }
            else if (kind == ST_G3) { J.A = Hb; J.lda = DM; J.B = (const bf16_t*)(ws + WS_WUP) + (size_t)L * UPW * DM; J.ldb = DM; J.K = DM; J.nM = mrows / 256; J.nN = UPW / 256; J.O = U; J.ldc = FFN; J.mode = 2;
                J.cw = pp->in[18] + (size_t)L * 3 * FFN; J.cb = pp->in[19] + (size_t)L * FFN; J.zp = (float*)(ws + WS_ZP); J.gv = (float*)(ws + WS_GV); J.vv = (float*)(ws + WS_VV); }
            else { J.A = U; J.lda = FFN; J.B = (const bf16_t*)(ws + WS_WDN) + (size_t)L * DM * FFN; J.ldb = FFN; J.K = FFN; J.nM = ML / 256; J.nN = DM / 256; J.O = MIX; J.ldc = DM;
                if (j == 1) { J.A = U + (size_t)ML * FFN; J.nM = MC / 256; J.ksplit = 4; J.K = FFN / 4; J.O = YPART; J.ostride_ks = (long)MC * DM; }
                if (lastL) { J.mode = 4; J.xs = XS; J.outf = pp->out; J.gate = modL + 5 * DM; J.gpost = pp->in[9] + L * DM; J.xbuf = (float*)(ws + WS_MODP); J.pcnt = (unsigned*)ws + 4096; } }
            J.astride = (long)256 * J.lda; J.bstride_n = (long)256 * J.ldb;
            pg8::StaticOrder S; S.init(J.nM, J.nN * J.ksplit, G, bid); S.panel = (J.mode == 4);
            if (kind == ST_G1 && tid < 256) ((LAS float*)(lds + CWL_OFF))[tid] = tid < 128 ? pp->in[11][L * 128 + tid] : pp->in[12][L * 128 + tid - 128];
            __syncthreads();
            pg8::gemm_phase(lds, J, S, tid);
        }
        if (gridDim.y == 0x7fff) grid.sync();
        { XcdBarrier xb; xb.bar = (unsigned*)ws; xb.x = xb_xcc_id(); xb.st = (volatile LAS unsigned*)(lds + 131072); xcd_barrier(xb, tid); }
    }
}

extern "C" void kernel_launch(void* const* d_in, const int* in_sizes, int n_in, void* d_out, int out_size, void* d_ws, size_t ws_size, hipStream_t stream) {
    static int grid = 0;
    if (grid == 0) {
        if (n_in != 21 || out_size != ML * DM || ws_size < WS_END) { fprintf(stderr, "kernel_launch: unexpected shapes: n_in %d out %d ws %zu (need %zu)\n", n_in, out_size, ws_size, (size_t)WS_END); grid = -1; return; }
        int dev = 0, cus = 0, per_cu = 0;
        (void)hipGetDevice(&dev); (void)hipDeviceGetAttribute(&cus, hipDeviceAttributeMultiprocessorCount, dev);
        if (hipFuncSetAttribute((const void*)fwd_megakernel, hipFuncAttributeMaxDynamicSharedMemorySize, LDS_BYTES) != hipSuccess) { fprintf(stderr, "kernel_launch: hipFuncSetAttribute failed\n"); grid = -1; return; }
        if (hipOccupancyMaxActiveBlocksPerMultiprocessor(&per_cu, (const void*)fwd_megakernel, NTHREADS, LDS_BYTES) != hipSuccess || per_cu < 1) { fprintf(stderr, "kernel_launch: occupancy query gave %d\n", per_cu); (void)hipGetLastError(); per_cu = 1; }
        grid = cus;
        if (grid > cus * per_cu) grid = cus * per_cu;
    }
    if (grid < 0) return;
    if (hipMemsetAsync(d_ws, 0, 65536, stream) != hipSuccess) { fprintf(stderr, "kernel_launch: hipMemsetAsync failed\n"); return; }
    Params p{};
    for (int i = 0; i < 21; ++i) p.in[i] = (const float*)d_in[i];
    p.out = (float*)d_out; p.ws = (unsigned char*)d_ws;
    void* args[] = {&p};
    hipError_t e = hipLaunchCooperativeKernel((const void*)fwd_megakernel, dim3(grid), dim3(NTHREADS), args, LDS_BYTES, stream);
    if (e != hipSuccess) fprintf(stderr, "cooperative launch failed: %s (grid %d)\n", hipGetErrorString(e), grid);
}
```

```cpp
#include <hip/hip_runtime.h>
#include <hip/hip_bf16.h>
#include <hip/hip_cooperative_groups.h>
#include <cstdio>
#include <cstdint>
namespace cg = cooperative_groups;

constexpr int DM = 2048, NB = 8, SEQ = 2048, CTXL = 256, DEPTH = 2;
constexpr int ML = NB * SEQ, MC = NB * CTXL, MT = ML + MC;
constexpr int INW = 2560, QKVW = 1536, FFN = 5632, UPW = 2 * FFN, NMODC = 6 * DM;
constexpr int SKV = SEQ + CTXL;
constexpr float EPS = 1e-6f;
constexpr int NTHREADS = 512, NWAVES = 8;

#define LAS __attribute__((address_space(3)))
typedef unsigned short bf16_t;
typedef short bf16x8 __attribute__((ext_vector_type(8)));
typedef float f32x4 __attribute__((ext_vector_type(4)));
typedef float f32x2 __attribute__((ext_vector_type(2)));
typedef unsigned u32x4 __attribute__((ext_vector_type(4)));
typedef unsigned u32x2 __attribute__((ext_vector_type(2)));
using f32x16 = __attribute__((ext_vector_type(16))) float;
using s16x4 = __attribute__((ext_vector_type(4))) short;

constexpr size_t MiB = 1u << 20;
constexpr size_t WS_MOD = 1 * MiB;
constexpr size_t WS_MODP = 2 * MiB;
constexpr size_t WS_CWS = 16 * MiB;
constexpr size_t WS_D256 = 17 * MiB;
constexpr size_t WS_D2048 = 18 * MiB;
constexpr size_t WS_WIN = 34 * MiB;
constexpr size_t WS_WOUT = 54 * MiB;
constexpr size_t WS_WUP = 70 * MiB;
constexpr size_t WS_WDN = 158 * MiB;
constexpr size_t WS_XC = 202 * MiB;
constexpr size_t WS_H = 218 * MiB;
constexpr size_t WS_MIX = 290 * MiB;
constexpr size_t WS_R1 = 362 * MiB;
constexpr size_t WS_P = WS_R1;
constexpr size_t WS_QN = WS_R1 + 90 * MiB;
constexpr size_t WS_KALL = WS_R1 + 126 * MiB;
constexpr size_t WS_VALL = WS_R1 + 135 * MiB;
constexpr size_t WS_YTL = WS_R1 + 144 * MiB;
constexpr size_t WS_YTC = WS_R1 + 208 * MiB;
constexpr size_t WS_ATTO = WS_R1 + 216 * MiB;
constexpr size_t WS_FOURO = WS_R1 + 252 * MiB;
constexpr size_t WS_ZP = WS_R1 + 200 * MiB;
constexpr size_t WS_GV = WS_R1 + 207 * MiB;
constexpr size_t WS_VV = WS_R1 + 214 * MiB;
constexpr size_t WS_NYQ = 1 * MiB + 960 * 1024;
constexpr size_t WS_YPART = WS_R1 + 288 * MiB;
constexpr size_t WS_XS = WS_R1 + 320 * MiB;
constexpr size_t WS_END = WS_R1 + 396 * MiB;
constexpr int CWL_OFF = 131072 + 1024;
constexpr int QKP_OFF = CWL_OFF + 4096;
constexpr int LDS_BYTES = 131072 + 1024 + 4096 + 8192;

struct Params { const float* in[21]; float* out; unsigned char* ws; };
typedef const __attribute__((address_space(4))) Params* KP;

__device__ __forceinline__ unsigned cvt_pk_bf16(float lo, float hi) { unsigned r; asm volatile("v_cvt_pk_bf16_f32 %0, %1, %2" : "=v"(r) : "v"(lo), "v"(hi)); return r; }
__device__ __forceinline__ float bf_lo(unsigned w) { return __uint_as_float(w << 16); }
__device__ __forceinline__ float bf_hi(unsigned w) { return __uint_as_float(w & 0xffff0000u); }
template <int K> __device__ __forceinline__ float xor_get(float v) { return __uint_as_float((unsigned)__builtin_amdgcn_ds_swizzle((int)__float_as_uint(v), (K << 10) | 0x1f)); }
__device__ __forceinline__ float half_sum(float v) { auto rr = __builtin_amdgcn_permlane32_swap(__float_as_uint(v), __float_as_uint(v), false, false); return __uint_as_float(rr[0]) + __uint_as_float(rr[1]); }
__device__ __forceinline__ float wave_sum(float v) {
    v += xor_get<1>(v); v += xor_get<2>(v); v += xor_get<4>(v); v += xor_get<8>(v); v += xor_get<16>(v);
    return half_sum(v);
}
__device__ __forceinline__ float gelu_tanh(float z) {
    const float t = z * (0.044715f * z * z + 1.f);
    const float e = __builtin_amdgcn_exp2f(t * (-2.f * 0.7978845608028654f * 1.4426950408889634f));
    return z * __builtin_amdgcn_rcpf(1.f + e);
}

namespace pg8 {
constexpr int BM = 256, BK = 64, HALF = 128, HTB = HALF * BK * 2, STAGE_BYTES = 8 * HTB, NXCD = 8, WGM = 8;
__device__ __forceinline__ int lds_byte(int r, int c) { const int st = (r >> 4) * 2 + (c >> 5), rr = r & 15, cc = c & 31, ob = rr * 64 + cc * 2; return st * 1024 + (ob ^ (((ob >> 9) & 1) << 5)); }
__device__ __forceinline__ void stage_rc(int b, int& R, int& C) { const int st = b / 1024, sb = b % 1024, swz = sb ^ (((sb >> 9) & 1) << 5); R = (st >> 1) * 16 + swz / 64; C = (st & 1) * 32 + (swz % 64) / 2; }
__device__ __forceinline__ int perm32(int rho) { const int n = rho >> 4, i = rho & 15; return 8 * (i >> 2) + 4 * n + (i & 3); }

struct Unit { int pm, pn, ks; };
struct Job {
    const bf16_t* A; const bf16_t* B; bf16_t* O;
    int lda, ldb, ldc, K, nM, nN;
    int ksplit; long ostride_ks;
    int amod, bdiv; long astride, bstride_m, bstride_n;
    int mode; float scale; bf16_t* O2;
    KP pp; unsigned char* ws; int L, which;
    __device__ __forceinline__ const char* aptr(const Unit& u) const { return (const char*)(A + (size_t)(u.pm % amod) * astride + (size_t)u.ks * K); }
    __device__ __forceinline__ const char* bptr(const Unit& u) const { return (const char*)(B + (size_t)(u.pm / bdiv) * bstride_m + (size_t)u.pn * bstride_n + (size_t)u.ks * K); }
};
struct StaticOrder {
    int nM, nN, nwg, G, c, panel;
    __device__ void init(int nM_, int nN_, int G_, int c_) { nM = nM_; nN = nN_; nwg = nM * nN; G = G_; c = c_; panel = 0; }
    __device__ bool next(int i, Unit& u) const {
        if (panel) { const int cp = (G % 8 == 0) ? (c % 8) * (G / 8) + c / 8 : c; const long Lp = (long)i * G + cp; if (Lp >= nwg) return false; u.pm = (int)(Lp / nN); u.pn = (int)(Lp % nN); u.ks = 0; return true; }
        const long L = (long)i * G + c; if (L >= nwg) return false;
        int wgid = (int)L; { const int q = nwg / NXCD, r = nwg % NXCD, xcd = wgid % NXCD, off = wgid / NXCD; wgid = (xcd < r ? xcd * (q + 1) : r * (q + 1) + (xcd - r) * q) + off; }
        const int nig = WGM * nN, gid = wgid / nig, fm = gid * WGM, gsz = (nM - fm) < WGM ? (nM - fm) : WGM;
        u.pm = fm + ((wgid % nig) % gsz); u.pn = (wgid % nig) / gsz; u.ks = 0; return true;
    }
};

__device__ __forceinline__ void panel_rstd(float (&sq)[2][4], float* xbuf, unsigned* pcnt, const Unit& u, int wr, int wc, int fr, int fq, LAS unsigned char* lds) {
    const int lane = fq * 16 + fr, wid = wr * 4 + wc, rl0 = wr * 64 + fr;
    LAS float* part = (LAS float*)(lds + QKP_OFF);
    LAS float* Srs = part + 1024;
#pragma unroll
    for (int ai = 0; ai < 2; ++ai)
#pragma unroll
        for (int m = 0; m < 4; ++m) { float t = sq[ai][m]; t += xor_get<16>(t); t = half_sum(t);
            if (fq == 0) part[(rl0 + 128 * ai + 16 * m) * 4 + wc] = t; }
    asm volatile("s_waitcnt lgkmcnt(0)" ::: "memory"); __builtin_amdgcn_s_barrier(); asm volatile("" ::: "memory");
    const int prow = wid * 32 + (lane & 31);
    if (lane < 32) { const f32x4 p4 = *(const LAS f32x4*)(part + prow * 4);
        __hip_atomic_store(xbuf + ((size_t)u.pm * BM + prow) * 8 + u.pn, (p4[0] + p4[1]) + (p4[2] + p4[3]), __ATOMIC_RELAXED, __HIP_MEMORY_SCOPE_AGENT); }
    asm volatile("s_waitcnt vmcnt(0)" ::: "memory");
    if (lane == 0) __hip_atomic_fetch_add(pcnt + 64 * u.pm, 1u, __ATOMIC_RELAXED, __HIP_MEMORY_SCOPE_AGENT);
    if (wid == 0) { unsigned sp = 0;
        while ((unsigned)__builtin_amdgcn_readfirstlane((int)__hip_atomic_load(pcnt + 64 * u.pm, __ATOMIC_RELAXED, __HIP_MEMORY_SCOPE_AGENT)) < 64u) { __builtin_amdgcn_s_sleep(2); if (++sp > (1u << 16)) break; }
        __builtin_amdgcn_fence(__ATOMIC_ACQUIRE, "agent"); }
    asm volatile("s_waitcnt vmcnt(0) lgkmcnt(0)" ::: "memory"); __builtin_amdgcn_s_barrier(); asm volatile("" ::: "memory");
    if (lane < 32) { const float* xb = xbuf + ((size_t)u.pm * BM + prow) * 8; float t = 0.f;
#pragma unroll
        for (int q = 0; q < 8; ++q) t += __hip_atomic_load(xb + q, __ATOMIC_RELAXED, __HIP_MEMORY_SCOPE_AGENT);
        Srs[prow] = __builtin_amdgcn_rsqf(t * (1.f / DM) + EPS); }
    asm volatile("s_waitcnt lgkmcnt(0)" ::: "memory"); __builtin_amdgcn_s_barrier(); asm volatile("" ::: "memory");
}
__device__ __forceinline__ void epilogue(const Job& J, const f32x4 (&acc)[2][2][4][2], const Unit& u, int wr, int wc, int fr, int fq, LAS unsigned char* lds, int upar) {
    asm volatile("" : "+v"(fr), "+v"(fq));
    const float sc = J.scale;
    if (J.mode == 0 || (J.mode == 3 && u.pn >= 6)) {
        const int row0 = u.pm * BM + wr * 64 + fr, col0 = u.pn * BM + wc * 32 + 8 * fq;
#pragma unroll
        for (int ai = 0; ai < 2; ++ai)
#pragma unroll
            for (int m = 0; m < 4; ++m) { bf16_t* rowp = J.O + (size_t)u.ks * J.ostride_ks + (size_t)(row0 + ai * HALF + m * 16) * J.ldc + col0;
#pragma unroll
                for (int bj = 0; bj < 2; ++bj) { const f32x4 v0 = acc[ai][bj][m][0] * sc, v1 = acc[ai][bj][m][1] * sc;
                    u32x4 w; w.x = cvt_pk_bf16(v0[0], v0[1]); w.y = cvt_pk_bf16(v0[2], v0[3]); w.z = cvt_pk_bf16(v1[0], v1[1]); w.w = cvt_pk_bf16(v1[2], v1[3]);
                    *(u32x4*)(rowp + bj * HALF) = w; } }
    } else if (J.mode == 4 || J.mode == 5) {
        const int rl0 = wr * 64 + fr;
        const LAS float* Srs = (const LAS float*)(lds + QKP_OFF) + 1024;
        float sq[2][4];
#pragma unroll
        for (int ai = 0; ai < 2; ++ai)
#pragma unroll
            for (int m = 0; m < 4; ++m) { float t = 0.f;
#pragma unroll
                for (int bj = 0; bj < 2; ++bj)
#pragma unroll
                    for (int n = 0; n < 2; ++n) { const f32x4 a = acc[ai][bj][m][n]; t += (a[0] * a[0] + a[1] * a[1]) + (a[2] * a[2] + a[3] * a[3]); }
                sq[ai][m] = t; }
        const int Lk = J.L, wh = J.which;
        unsigned char* ws = J.ws; KP pp = J.pp; asm volatile("" : "+v"(ws));
        const float* modL = (const float*)(ws + WS_MOD) + (size_t)Lk * 9 * NMODC;
        const int bank = 4 * Lk + 2 * wh;
        float* xbuf1 = (float*)(ws + WS_MODP) + (size_t)bank * (ML * 8); unsigned* pcnt1 = (unsigned*)ws + 4096 + bank * 4096;
        const bf16_t* xs_in = (wh == 0 && Lk == 0) ? nullptr : (const bf16_t*)(ws + WS_XS);
        panel_rstd(sq, xbuf1, pcnt1, u, wr, wc, fr, fq, lds);
        const int col0 = u.pn * BM + wc * 32 + 8 * fq, mr = u.pm >> 3;
        const float* gt = modL + (wh == 0 ? 2 : 5) * DM + (size_t)mr * NMODC + col0; const float* gp0 = pp->in[wh == 0 ? 7 : 9]; asm volatile("" : "+v"(gp0)); const float* gp = gp0 + Lk * DM + col0;
#pragma unroll
        for (int ai = 0; ai < 2; ++ai)
#pragma unroll
            for (int m = 0; m < 4; ++m) sq[ai][m] = 0.f;
#pragma unroll
        for (int bj = 0; bj < 2; ++bj) {
            float gg[8];
#pragma unroll
            for (int h = 0; h < 2; ++h) { const f32x4 a = *(const f32x4*)(gt + bj * HALF + 4 * h), b = *(const f32x4*)(gp + bj * HALF + 4 * h);
#pragma unroll
                for (int i = 0; i < 4; ++i) gg[4 * h + i] = a[i] * b[i]; }
#pragma unroll
            for (int ai = 0; ai < 2; ++ai)
#pragma unroll
                for (int m = 0; m < 4; ++m) { const int r = rl0 + 128 * ai + 16 * m; const float rs = Srs[r]; const size_t off = ((size_t)u.pm * BM + r) * DM + col0 + bj * HALF;
                    float x[8];
                    if (xs_in) { const u32x4 xw = *(const u32x4*)(xs_in + off); x[0] = bf_lo(xw.x); x[1] = bf_hi(xw.x); x[2] = bf_lo(xw.y); x[3] = bf_hi(xw.y); x[4] = bf_lo(xw.z); x[5] = bf_hi(xw.z); x[6] = bf_lo(xw.w); x[7] = bf_hi(xw.w); }
                    else { const float* xf = pp->in[0]; asm volatile("" : "+v"(xf)); const f32x4 a = *(const f32x4*)(xf + off), b = *(const f32x4*)(xf + off + 4); x[0] = a[0]; x[1] = a[1]; x[2] = a[2]; x[3] = a[3]; x[4] = b[0]; x[5] = b[1]; x[6] = b[2]; x[7] = b[3]; }
#pragma unroll
                    for (int e = 0; e < 8; ++e) x[e] += gg[e] * rs * acc[ai][bj][m][e >> 2][e & 3];
                    if (J.mode == 4) { float* outf = pp->out; asm volatile("" : "+v"(outf)); *(f32x4*)(outf + off) = (f32x4){x[0], x[1], x[2], x[3]}; *(f32x4*)(outf + off + 4) = (f32x4){x[4], x[5], x[6], x[7]}; }
                    else { u32x4 w; w.x = cvt_pk_bf16(x[0], x[1]); w.y = cvt_pk_bf16(x[2], x[3]); w.z = cvt_pk_bf16(x[4], x[5]); w.w = cvt_pk_bf16(x[6], x[7]);
                        *(u32x4*)((bf16_t*)(ws + WS_XS) + off) = w;
                        const float r0 = bf_lo(w.x), r1 = bf_hi(w.x), r2 = bf_lo(w.y), r3 = bf_hi(w.y), r4 = bf_lo(w.z), r5 = bf_hi(w.z), r6 = bf_lo(w.w), r7 = bf_hi(w.w);
                        sq[ai][m] += (r0 * r0 + r1 * r1) + (r2 * r2 + r3 * r3) + (r4 * r4 + r5 * r5) + (r6 * r6 + r7 * r7); }
                    __builtin_amdgcn_sched_barrier(0); }
        }
        if (J.mode == 5) {
            panel_rstd(sq, xbuf1 + (size_t)(ML * 8), pcnt1 + 4096, u, wr, wc, fr, fq, lds);
            const float* modN = wh == 0 ? modL + 3 * DM : modL + 9 * NMODC;
            const float* sh = modN + (size_t)mr * NMODC + col0; const float* scl = sh + DM; const float* gpr0 = wh == 0 ? pp->in[8] + Lk * DM : pp->in[6] + (Lk + 1) * DM; asm volatile("" : "+v"(gpr0)); const float* gpr = gpr0 + col0;
            bf16_t* Hout = (bf16_t*)(ws + (wh == 0 ? WS_MIX : WS_H));
#pragma unroll
            for (int bj = 0; bj < 2; ++bj) {
                float gs[8], sv[8];
#pragma unroll
                for (int h = 0; h < 2; ++h) { const f32x4 a = *(const f32x4*)(gpr + bj * HALF + 4 * h), b = *(const f32x4*)(scl + bj * HALF + 4 * h), c = *(const f32x4*)(sh + bj * HALF + 4 * h);
#pragma unroll
                    for (int i = 0; i < 4; ++i) { gs[4 * h + i] = a[i] * (b[i] + 1.f); sv[4 * h + i] = c[i]; } }
#pragma unroll
                for (int ai = 0; ai < 2; ++ai)
#pragma unroll
                    for (int m = 0; m < 4; ++m) { const int r = rl0 + 128 * ai + 16 * m; const float rs = Srs[r]; const size_t off = ((size_t)u.pm * BM + r) * DM + col0 + bj * HALF;
                        const u32x4 xw = *(const u32x4*)((const bf16_t*)(ws + WS_XS) + off);
                        float xv[8]; xv[0] = bf_lo(xw.x); xv[1] = bf_hi(xw.x); xv[2] = bf_lo(xw.y); xv[3] = bf_hi(xw.y); xv[4] = bf_lo(xw.z); xv[5] = bf_hi(xw.z); xv[6] = bf_lo(xw.w); xv[7] = bf_hi(xw.w);
                        float h[8];
#pragma unroll
                        for (int e = 0; e < 8; ++e) h[e] = xv[e] * rs * gs[e] + sv[e];
                        u32x4 w; w.x = cvt_pk_bf16(h[0], h[1]); w.y = cvt_pk_bf16(h[2], h[3]); w.z = cvt_pk_bf16(h[4], h[5]); w.w = cvt_pk_bf16(h[6], h[7]);
                        *(u32x4*)(Hout + off) = w;
                        __builtin_amdgcn_sched_barrier(0); }
            }
        }
    } else if (J.mode == 3) {
        const bool lat = u.pm < 64, nrm = u.pn < 5;
        const int rl0 = wr * 64 + fr, cl = wc * 32 + 8 * fq;
        if (nrm) {
            LAS float* part = (LAS float*)(lds + QKP_OFF);
#pragma unroll
            for (int ai = 0; ai < 2; ++ai)
#pragma unroll
                for (int m = 0; m < 4; ++m)
#pragma unroll
                    for (int bj = 0; bj < 2; ++bj) { const f32x4 a = acc[ai][bj][m][0], b = acc[ai][bj][m][1];
                        float sq = (a[0] * a[0] + a[1] * a[1]) + (a[2] * a[2] + a[3] * a[3]) + (b[0] * b[0] + b[1] * b[1]) + (b[2] * b[2] + b[3] * b[3]);
                        sq += xor_get<16>(sq); sq = half_sum(sq);
                        if (fq == 0) part[(rl0 + 128 * ai + 16 * m) * 8 + bj * 4 + wc] = sq; }
            asm volatile("s_waitcnt lgkmcnt(0)" ::: "memory"); __builtin_amdgcn_s_barrier(); asm volatile("" ::: "memory");
        }
        const LAS float* nw = (const LAS float*)(lds + CWL_OFF) + (u.pn == 4 ? 128 : 0) + cl;
        float gw[8];
        { const f32x4 a = *(const LAS f32x4*)nw, b = *(const LAS f32x4*)(nw + 4); gw[0] = a[0]; gw[1] = a[1]; gw[2] = a[2]; gw[3] = a[3]; gw[4] = b[0]; gw[5] = b[1]; gw[6] = b[2]; gw[7] = b[3]; }
        float frq[4];
#pragma unroll
        for (int i = 0; i < 4; ++i) frq[i] = __builtin_amdgcn_exp2f(-(float)((16 * wc + 4 * fq + i) & 31) * (13.287712379549449f / 32.f));
#pragma unroll
        for (int ai = 0; ai < 2; ++ai)
#pragma unroll
            for (int m = 0; m < 4; ++m) {
                const int rl = rl0 + 128 * ai + 16 * m, t = ((u.pm & 7) << 8) + rl;
                float cs[4], sn[4];
#pragma unroll
                for (int i = 0; i < 4; ++i) { cs[i] = 1.f; sn[i] = 0.f; }
                if (lat && nrm) { const float pos = (float)(wc < 2 ? (t >> 6) : (t & 63));
#pragma unroll
                    for (int i = 0; i < 4; ++i) { float rev = pos * frq[i] * 0.15915494309189535f; rev -= floorf(rev); cs[i] = __builtin_amdgcn_cosf(rev); sn[i] = __builtin_amdgcn_sinf(rev); } }
                const size_t row = (size_t)u.pm * BM + rl;
                const size_t kvrow = lat ? (size_t)(u.pm >> 3) * SKV + t : (size_t)(u.pm - 64) * SKV + SEQ + rl;
#pragma unroll
                for (int bj = 0; bj < 2; ++bj) {
                    float v[8];
#pragma unroll
                    for (int e = 0; e < 8; ++e) v[e] = acc[ai][bj][m][e >> 2][e & 3];
                    if (nrm) { const f32x4 p4 = *(const LAS f32x4*)((const LAS float*)(lds + QKP_OFF) + rl * 8 + bj * 4);
                        const float rs = __builtin_amdgcn_rsqf(((p4[0] + p4[1]) + (p4[2] + p4[3])) * (1.f / 128.f) + EPS);
#pragma unroll
                        for (int i = 0; i < 4; ++i) { const float e0 = v[2 * i] * rs * gw[2 * i], o0 = v[2 * i + 1] * rs * gw[2 * i + 1];
                            v[2 * i] = e0 * cs[i] - o0 * sn[i]; v[2 * i + 1] = e0 * sn[i] + o0 * cs[i]; } }
                    u32x4 w; w.x = cvt_pk_bf16(v[0], v[1]); w.y = cvt_pk_bf16(v[2], v[3]); w.z = cvt_pk_bf16(v[4], v[5]); w.w = cvt_pk_bf16(v[6], v[7]);
                    bf16_t* dst = u.pn < 4 ? (bf16_t*)(J.ws + WS_QN) + row * 1024 + (2 * u.pn + bj) * 128 + cl : (bf16_t*)(J.ws + (u.pn == 4 ? WS_KALL : WS_VALL)) + kvrow * 256 + bj * 128 + cl;
                    *(u32x4*)dst = w;
                }
                __builtin_amdgcn_sched_barrier(0);
            }
    } else if (J.mode == 2) {
        const int colg = u.pn * 128 + wc * 32 + 8 * fq, rowb = u.pm * BM + wr * 128 + fr * 8;
        const LAS float* cwl = (const LAS float*)(lds + CWL_OFF + upar * 2048) + wc * 32 + 8 * fq;
        f32x2 w0[4], w1[4], w2[4], bb[4];
#pragma unroll
        for (int h = 0; h < 2; ++h) { const f32x4 a = *(const LAS f32x4*)(cwl + 4 * h), b = *(const LAS f32x4*)(cwl + 128 + 4 * h), c = *(const LAS f32x4*)(cwl + 256 + 4 * h), d = *(const LAS f32x4*)(cwl + 384 + 4 * h);
            w0[2 * h] = (f32x2){a[0], a[1]}; w0[2 * h + 1] = (f32x2){a[2], a[3]}; w1[2 * h] = (f32x2){b[0], b[1]}; w1[2 * h + 1] = (f32x2){b[2], b[3]};
            w2[2 * h] = (f32x2){c[0], c[1]}; w2[2 * h + 1] = (f32x2){c[2], c[3]}; bb[2 * h] = (f32x2){d[0], d[1]}; bb[2 * h + 1] = (f32x2){d[2], d[3]}; }
#define GP2(j, q) ((f32x2){acc[(j) >> 2][0][(j) & 3][(q) >> 1][((q) & 1) * 2], acc[(j) >> 2][0][(j) & 3][(q) >> 1][((q) & 1) * 2 + 1]})
#define VP2(j, q) ((f32x2){acc[(j) >> 2][1][(j) & 3][(q) >> 1][((q) & 1) * 2], acc[(j) >> 2][1][(j) & 3][(q) >> 1][((q) & 1) * 2 + 1]})
        f32x2 gprev[4], gnext[4];
#pragma unroll
        for (int q = 0; q < 4; ++q) {
            const f32x2 last = GP2(7, q), first = GP2(0, q);
            gprev[q].x = __uint_as_float((unsigned)__builtin_amdgcn_update_dpp(0, (int)__float_as_uint(last.x), 0x111, 0xf, 0xf, false));
            gprev[q].y = __uint_as_float((unsigned)__builtin_amdgcn_update_dpp(0, (int)__float_as_uint(last.y), 0x111, 0xf, 0xf, false));
            gnext[q].x = __uint_as_float((unsigned)__builtin_amdgcn_update_dpp(0, (int)__float_as_uint(first.x), 0x101, 0xf, 0xf, false));
            gnext[q].y = __uint_as_float((unsigned)__builtin_amdgcn_update_dpp(0, (int)__float_as_uint(first.y), 0x101, 0xf, 0xf, false));
        }
        bf16_t* orow = J.O + (size_t)rowb * FFN + colg;
#pragma unroll
        for (int j = 0; j < 8; ++j) {
            f32x2 z[4]; unsigned ow[4];
#pragma unroll
            for (int q = 0; q < 4; ++q) {
                const f32x2 gp = j == 0 ? gprev[q] : GP2(j == 0 ? 0 : j - 1, q);
                const f32x2 gn = j == 7 ? gnext[q] : GP2(j == 7 ? 7 : j + 1, q);
                z[q] = gp * w0[q] + (GP2(j, q) * w1[q] + (gn * w2[q] + bb[q]));
                const f32x2 zz = z[q], t = zz * (zz * zz * 0.044715f + 1.0f), ex = t * (-2.302208198f);
                f32x2 d; d.x = __builtin_amdgcn_exp2f(ex.x); d.y = __builtin_amdgcn_exp2f(ex.y); d = d + 1.0f;
                f32x2 r; r.x = __builtin_amdgcn_rcpf(d.x); r.y = __builtin_amdgcn_rcpf(d.y);
                const f32x2 a = zz * r * VP2(j, q);
                ow[q] = cvt_pk_bf16(a.x, a.y);
            }
            u32x4 w; w.x = ow[0]; w.y = ow[1]; w.z = ow[2]; w.w = ow[3];
            *(u32x4*)(orow + (size_t)j * FFN) = w;
            if ((j == 0 && fr == 0) || (j == 7 && fr == 15)) {
                const size_t sb = (size_t)(u.pm * 4 + wr * 2 + (j == 7 ? 1 : 0)) * FFN + colg;
                *(f32x4*)((float*)(J.ws + WS_ZP) + sb) = (f32x4){z[0].x, z[0].y, z[1].x, z[1].y}; *(f32x4*)((float*)(J.ws + WS_ZP) + sb + 4) = (f32x4){z[2].x, z[2].y, z[3].x, z[3].y};
                *(f32x4*)((float*)(J.ws + WS_GV) + sb) = acc[j >> 2][0][j & 3][0]; *(f32x4*)((float*)(J.ws + WS_GV) + sb + 4) = acc[j >> 2][0][j & 3][1];
                *(f32x4*)((float*)(J.ws + WS_VV) + sb) = acc[j >> 2][1][j & 3][0]; *(f32x4*)((float*)(J.ws + WS_VV) + sb + 4) = acc[j >> 2][1][j & 3][1];
            }
        }
#undef GP2
#undef VP2
    } else {
        const bool lat = u.pn < 64;
        const int b = lat ? (u.pn >> 3) : (u.pn - 64), tbase = lat ? (u.pn & 7) * 256 : 0;
        const int ldy = lat ? SEQ : 2 * CTXL; const size_t halfoff = lat ? (size_t)1024 * SEQ : (size_t)CTXL;
        bf16_t* base = (lat ? J.O + (size_t)(b * 2048 + u.pm * 128) * ldy : J.O2 + (size_t)(b * 1024 + u.pm * 128) * ldy) + tbase + wc * 32 + 8 * fq;
#pragma unroll
        for (int ai = 0; ai < 2; ++ai)
#pragma unroll
            for (int m = 0; m < 4; ++m) { bf16_t* rowp = base + (size_t)(wr * 64 + m * 16 + fr) * ldy + ai * halfoff;
#pragma unroll
                for (int bj = 0; bj < 2; ++bj) { const f32x4 v0 = acc[ai][bj][m][0] * sc, v1 = acc[ai][bj][m][1] * sc;
                    u32x4 w; w.x = cvt_pk_bf16(v0[0], v0[1]); w.y = cvt_pk_bf16(v0[2], v0[3]); w.z = cvt_pk_bf16(v1[0], v1[1]); w.w = cvt_pk_bf16(v1[2], v1[3]);
                    *(u32x4*)(rowp + bj * HALF) = w; } }
    }
}

__device__ __forceinline__ void gemm_phase(LAS unsigned char* lds, const Job& g, const StaticOrder& S, const int tid) {
    const int wid = __builtin_amdgcn_readfirstlane(tid >> 6), lane = tid & 63, wr = wid >> 2, wc = wid & 3, fr = lane & 15, fq = lane >> 4;
    const int K = g.K, nt = K / BK;
    unsigned voffA[2], voffB[2];
#pragma unroll
    for (int i = 0; i < 2; ++i) { int R, C; stage_rc(tid * 16 + i * 8192, R, C); const int Rb = (R & ~31) + perm32(R & 31);
        const int Ra = g.mode == 2 ? ((R >> 6) * 128 + (R & 15) * 8 + ((R >> 4) & 3)) : R;
        voffA[i] = (unsigned)(Ra * g.lda + C) * 2u; voffB[i] = (unsigned)(Rb * g.ldb + C) * 2u; }
    const size_t kstep = (size_t)(BK * 2);
    const size_t hstepA = (size_t)(g.mode == 2 ? 4 : HALF) * g.lda * 2, hstepB = (size_t)HALF * g.ldb * 2;
    const unsigned ldsw = (unsigned)wid * 1024u;
    const int aoff = lds_byte(wr * 64 + fr, fq * 8), boff = lds_byte(wc * 32 + fr, fq * 8);
#define PG8_SA(b, h) (((b) * 2 + (h)) * HTB)
#define PG8_SB(b, h) ((4 + (b) * 2 + (h)) * HTB)
#define PG8_STAGE(bufoff, gbase, voff) do { _Pragma("unroll") for (int _i = 0; _i < 2; ++_i) \
        __builtin_amdgcn_global_load_lds((const unsigned*)((const char*)(gbase) + (voff)[_i]), (LAS unsigned*)(lds + (bufoff) + ldsw + _i * 8192), 16, 0, 0); } while (0)
#define PG8_LDA(dst, b, h) do { _Pragma("unroll") for (int m = 0; m < 4; ++m) _Pragma("unroll") for (int k = 0; k < 2; ++k) dst[m][k] = *(const LAS bf16x8*)(lds + PG8_SA(b, h) + aoff + m * 2048 + k * 1024); } while (0)
#define PG8_LDB(dst, b, h) do { _Pragma("unroll") for (int n = 0; n < 2; ++n) _Pragma("unroll") for (int k = 0; k < 2; ++k) dst[n][k] = *(const LAS bf16x8*)(lds + PG8_SB(b, h) + boff + n * 2048 + k * 1024); } while (0)
#define PG8_MMA(ai, bj, At, Bt) do { __builtin_amdgcn_s_setprio(1); _Pragma("unroll") for (int m = 0; m < 4; ++m) _Pragma("unroll") for (int n = 0; n < 2; ++n) _Pragma("unroll") for (int k = 0; k < 2; ++k) \
        acc[ai][bj][m][n] = __builtin_amdgcn_mfma_f32_16x16x32_bf16(Bt[n][k], At[m][k], acc[ai][bj][m][n], 0, 0, 0); __builtin_amdgcn_s_setprio(0); } while (0)
#define PG8_WAIT_V(n) asm volatile("s_waitcnt vmcnt(" #n ")" ::: "memory")
#define PG8_WAIT_L(n) asm volatile("s_waitcnt lgkmcnt(" #n ")" ::: "memory")
#define PG8_BAR __builtin_amdgcn_s_barrier()
#define PG8_SCHED __builtin_amdgcn_sched_barrier(0)
    Unit cur, nxt; int ui = 0;
#define PG8_FIXKS(u) do { if (g.ksplit > 1) { (u).ks = (u).pn / g.nN; (u).pn -= (u).ks * g.nN; } } while (0)
    if (!S.next(0, cur)) return;
    PG8_FIXKS(cur);
    f32x4 acc[2][2][4][2];
#pragma unroll
    for (int a = 0; a < 2; ++a)
#pragma unroll
        for (int b = 0; b < 2; ++b)
#pragma unroll
            for (int m = 0; m < 4; ++m)
#pragma unroll
                for (int n = 0; n < 2; ++n) acc[a][b][m][n] = (f32x4){0.f, 0.f, 0.f, 0.f};
    bf16x8 At[4][2], B0[2][2], B1[2][2];
    const char* cA = g.aptr(cur); const char* cB = g.bptr(cur);
    PG8_STAGE(PG8_SB(0, 0), cB, voffB); PG8_STAGE(PG8_SB(0, 1), cB + hstepB, voffB); PG8_STAGE(PG8_SA(0, 0), cA, voffA); PG8_STAGE(PG8_SA(0, 1), cA + hstepA, voffA);
    if (wr == 1) PG8_BAR;
    PG8_WAIT_V(2); PG8_BAR;
    PG8_STAGE(PG8_SB(1, 0), cB + kstep, voffB); PG8_STAGE(PG8_SA(1, 0), cA + kstep, voffA); PG8_STAGE(PG8_SB(1, 1), cB + hstepB + kstep, voffB);
    PG8_WAIT_V(6); PG8_BAR;
    for (;;) {
        const bool has_next = S.next(ui + 1, nxt);
        if (has_next) PG8_FIXKS(nxt);
        if (g.mode == 2) {
            const int arr = wid >> 1;
            const float* src = (arr < 3 ? g.pp->in[18] + (size_t)g.L * 3 * FFN + arr * FFN : g.pp->in[19] + (size_t)g.L * FFN) + cur.pn * 128 + (wid & 1) * 64 + lane;
            __builtin_amdgcn_global_load_lds((const unsigned*)src, (LAS unsigned*)(lds + CWL_OFF + (ui & 1) * 2048 + wid * 256), 4, 0, 0);
        }
        const char* nA = has_next ? g.aptr(nxt) : cA; const char* nB = has_next ? g.bptr(nxt) : cB;
        for (int t = 0; t < nt; t += 2) {
            const bool last = (t == nt - 2);
            const char* a1 = cA + (size_t)(t + 1) * kstep;
            const char* a2 = last ? nA : cA + (size_t)(t + 2) * kstep; const char* b2 = last ? nB : cB + (size_t)(t + 2) * kstep;
            const char* a3 = a2 + kstep; const char* b3 = b2 + kstep;
            PG8_LDB(B0, 0, 0); PG8_LDB(B1, 0, 1); PG8_SCHED; PG8_LDA(At, 0, 0); PG8_STAGE(PG8_SA(1, 1), a1 + hstepA, voffA);
            PG8_WAIT_V(8); PG8_WAIT_L(0); PG8_BAR; PG8_MMA(0, 0, At, B0); PG8_MMA(0, 1, At, B1); PG8_BAR; PG8_SCHED;
            PG8_LDA(At, 0, 1); PG8_STAGE(PG8_SB(0, 0), b2, voffB); PG8_STAGE(PG8_SB(0, 1), b2 + hstepB, voffB); PG8_STAGE(PG8_SA(0, 0), a2, voffA);
            PG8_WAIT_V(8); PG8_WAIT_L(0); PG8_BAR; PG8_MMA(1, 0, At, B0); PG8_MMA(1, 1, At, B1); PG8_BAR; PG8_SCHED;
            PG8_LDB(B0, 1, 0); PG8_LDB(B1, 1, 1); PG8_SCHED; PG8_LDA(At, 1, 0); PG8_STAGE(PG8_SA(0, 1), a2 + hstepA, voffA);
            PG8_WAIT_V(8); PG8_WAIT_L(0); PG8_BAR; PG8_MMA(0, 0, At, B0); PG8_MMA(0, 1, At, B1); PG8_BAR; PG8_SCHED;
            PG8_LDA(At, 1, 1); PG8_STAGE(PG8_SB(1, 0), b3, voffB); PG8_STAGE(PG8_SB(1, 1), b3 + hstepB, voffB); PG8_STAGE(PG8_SA(1, 0), a3, voffA);
            PG8_WAIT_V(8); PG8_WAIT_L(0); PG8_BAR; PG8_MMA(1, 0, At, B0); PG8_MMA(1, 1, At, B1); PG8_BAR; PG8_SCHED;
        }
        if (wr == 0) PG8_BAR;
        epilogue(g, acc, cur, wr, wc, fr, fq, lds, ui & 1);
        if (!has_next) break;
#pragma unroll
        for (int a = 0; a < 2; ++a)
#pragma unroll
            for (int b = 0; b < 2; ++b)
#pragma unroll
                for (int m = 0; m < 4; ++m)
#pragma unroll
                    for (int n = 0; n < 2; ++n) acc[a][b][m][n] = (f32x4){0.f, 0.f, 0.f, 0.f};
        cur = nxt; cA = nA; cB = nB; ++ui;
        if (wr == 1) PG8_BAR;
    }
    PG8_WAIT_V(0);
    PG8_BAR;
#undef PG8_FIXKS
#undef PG8_SA
#undef PG8_SB
#undef PG8_STAGE
#undef PG8_LDA
#undef PG8_LDB
#undef PG8_MMA
#undef PG8_WAIT_V
#undef PG8_WAIT_L
#undef PG8_BAR
#undef PG8_SCHED
}
}

namespace att {
using bf16 = __hip_bfloat16;
constexpr int D = 128, NW = 8, QBLK = 32, KVBLK = 64;
constexpr float SCALE = 0.088388347648318440f;
constexpr float THR = 8.f;
#ifndef ATT_SDEPTH
#define ATT_SDEPTH 2
#endif
constexpr int LDQ = 1024, LDK = 256, LDO = 1024;
constexpr size_t SHM_V = KVBLK * D * 2, SHM_K = KVBLK * D * 2, SHM_ATTN = 2 * SHM_V + 2 * SHM_K + NW * 64 * 4;
#define KSWZ(row, colB) ((row) * 256 + ((colB) ^ (((row) & 7) << 4)))
#define SBAR() __builtin_amdgcn_sched_barrier(0)
__device__ __forceinline__ int crow(int r, int hi) { return (r & 3) + 8 * (r >> 2) + 4 * hi; }
__device__ __forceinline__ unsigned cvtpk(float lo, float hi) { unsigned r; asm volatile("v_cvt_pk_bf16_f32 %0, %1, %2" : "=v"(r) : "v"(lo), "v"(hi)); return r; }
__device__ __forceinline__ bf16x8 ld8(const bf16* p) { return *reinterpret_cast<const bf16x8*>(p); }
__device__ __forceinline__ void partialSM(f32x16& p0, f32x16& p1, float& m_reg, float& mn, float& alpha) {
  constexpr float C = SCALE * 1.4426950408889634f;
  float pmax = p0[0]; for (int r = 1; r < 16; ++r) pmax = fmaxf(pmax, p0[r]); for (int r = 0; r < 16; ++r) pmax = fmaxf(pmax, p1[r]);
  { auto rr = __builtin_amdgcn_permlane32_swap(__float_as_uint(pmax), __float_as_uint(pmax), false, false);
    pmax = fmaxf(__uint_as_float(rr[0]), __uint_as_float(rr[1])); }
  if (__builtin_expect(__all(pmax - m_reg <= THR / SCALE), 1)) { mn = m_reg; alpha = 1.f; }
  else { mn = fmaxf(m_reg, pmax); alpha = __builtin_amdgcn_exp2f((m_reg - mn) * C); m_reg = mn; }
  float mnC = -mn * C;
  for (int r = 0; r < 16; ++r) p0[r] = fmaf(p0[r], C, mnC); for (int r = 0; r < 16; ++r) p1[r] = fmaf(p1[r], C, mnC);
  for (int r = 0; r < 16; ++r) p0[r] = __builtin_amdgcn_exp2f(p0[r]);
}
__device__ __forceinline__ void finishSM(f32x16& p0, f32x16& p1, float alpha, float& l_reg, bf16x8& pa0, bf16x8& pa1, bf16x8& pa2, bf16x8& pa3) {
  for (int r = 0; r < 16; ++r) p1[r] = __builtin_amdgcn_exp2f(p1[r]);
  float ps = 0; for (int r = 0; r < 16; ++r) ps += p0[r]; for (int r = 0; r < 16; ++r) ps += p1[r];
  { auto rr = __builtin_amdgcn_permlane32_swap(__float_as_uint(ps), __float_as_uint(ps), false, false);
    ps = __uint_as_float(rr[0]) + __uint_as_float(rr[1]); }
  l_reg = l_reg * alpha + ps;
#define PK4(P, BASE, OUT) do { unsigned a0 = cvtpk(P[BASE + 0], P[BASE + 1]), a1 = cvtpk(P[BASE + 2], P[BASE + 3]);   \
    unsigned b0 = cvtpk(P[BASE + 4], P[BASE + 5]), b1 = cvtpk(P[BASE + 6], P[BASE + 7]);                              \
    auto r0 = __builtin_amdgcn_permlane32_swap(a0, b0, false, false); auto r1 = __builtin_amdgcn_permlane32_swap(a1, b1, false, false); \
    u32x4 w = {r0[0], r1[0], r0[1], r1[1]}; OUT = *reinterpret_cast<bf16x8*>(&w); } while (0)
  PK4(p0, 0, pa0); PK4(p0, 8, pa1); PK4(p1, 0, pa2); PK4(p1, 8, pa3);
#undef PK4
}
__device__ __forceinline__ void qkt(f32x16& p0, f32x16& p1, const bf16* Ks, const bf16x8* qr, int r32, int hi) {
  p0 = f32x16{}; p1 = f32x16{};
  for (int d0 = 0; d0 < 8; ++d0) { int cb = (d0 * 16 + hi * 8) * 2;
    bf16x8 b0 = *reinterpret_cast<const bf16x8*>((const char*)Ks + KSWZ(r32, cb));
    bf16x8 b1 = *reinterpret_cast<const bf16x8*>((const char*)Ks + KSWZ(32 + r32, cb));
    p0 = __builtin_amdgcn_mfma_f32_32x32x16_bf16(b0, qr[d0], p0, 0, 0, 0);
    p1 = __builtin_amdgcn_mfma_f32_32x32x16_bf16(b1, qr[d0], p1, 0, 0, 0); }
}
__device__ __forceinline__ int v_st(int k, int c) { const int kk = (k & ~0xC) | ((k & 4) << 1) | ((k & 8) >> 1); return ((kk >> 3) * 4 + (c >> 5)) * 512 + ((kk & 7) * 32 + (c & 31)) * 2; }
__device__ __forceinline__ int v_rd_base(int lane) { return ((lane & 3) << 3) | (((lane >> 2) & 3) << 6) | (((lane >> 4) & 1) << 5) | (((lane >> 5) & 1) << 8); }
constexpr int v_rd_off(int d0, int ks, int half) { return d0 * 512 + ks * 4096 + half * 2048; }
template <int OFF> __device__ __forceinline__ s16x4 tr_read(int vb) {
  s16x4 r; asm volatile("ds_read_b64_tr_b16 %0, %1 offset:%2" : "=&v"(r) : "v"(vb), "i"(OFF) : "memory"); return r;
}
template <int D0> __device__ __forceinline__ void pv_one(f32x16& od, int vb, bf16x8 pa0, bf16x8 pa1, bf16x8 pa2, bf16x8 pa3) {
  const s16x4 l0 = tr_read<v_rd_off(D0, 0, 0)>(vb), h0 = tr_read<v_rd_off(D0, 0, 1)>(vb), l1 = tr_read<v_rd_off(D0, 1, 0)>(vb), h1 = tr_read<v_rd_off(D0, 1, 1)>(vb);
  const s16x4 l2 = tr_read<v_rd_off(D0, 2, 0)>(vb), h2 = tr_read<v_rd_off(D0, 2, 1)>(vb), l3 = tr_read<v_rd_off(D0, 3, 0)>(vb), h3 = tr_read<v_rd_off(D0, 3, 1)>(vb);
  asm volatile("s_waitcnt lgkmcnt(0)" ::: "memory"); SBAR();
#define PK(L, H) (bf16x8){L[0], L[1], L[2], L[3], H[0], H[1], H[2], H[3]}
  od = __builtin_amdgcn_mfma_f32_32x32x16_bf16(pa0, PK(l0, h0), od, 0, 0, 0);
  od = __builtin_amdgcn_mfma_f32_32x32x16_bf16(pa1, PK(l1, h1), od, 0, 0, 0);
  od = __builtin_amdgcn_mfma_f32_32x32x16_bf16(pa2, PK(l2, h2), od, 0, 0, 0);
  od = __builtin_amdgcn_mfma_f32_32x32x16_bf16(pa3, PK(l3, h3), od, 0, 0, 0);
#undef PK
}
__device__ __forceinline__ void pv_d0(f32x16* o, int vb, bf16x8 pa0, bf16x8 pa1, bf16x8 pa2, bf16x8 pa3) {
  pv_one<0>(o[0], vb, pa0, pa1, pa2, pa3); pv_one<1>(o[1], vb, pa0, pa1, pa2, pa3); pv_one<2>(o[2], vb, pa0, pa1, pa2, pa3); pv_one<3>(o[3], vb, pa0, pa1, pa2, pa3);
}
__device__ __forceinline__ void attn_dense_body(const bf16* __restrict__ Qb, const bf16* __restrict__ Kh, const bf16* __restrict__ Vh,
                                                bf16_t* __restrict__ Ob, int seq, char* lds, const int tid) {
  constexpr int SDEPTH = ATT_SDEPTH;
  const int wid = tid >> 6, lane = tid & 63, r32 = lane & 31, hi = lane >> 5;
  bf16* V_lds = (bf16*)lds; bf16* K_lds = (bf16*)(lds + 2 * SHM_V);
  float* ws = (float*)(lds + 2 * SHM_V + 2 * SHM_K) + wid * 64; float* li_l = ws; float* al_l = ws + 32;
  float m_reg = -1e30f, l_reg = 0; f32x16 o[4] = {}; bf16x8 qr[8];
  const bf16* Qw = Qb + (long)(wid * QBLK + r32) * LDQ + hi * 8;
#pragma unroll
  for (int d0 = 0; d0 < 8; ++d0) qr[d0] = ld8(Qw + d0 * 16);
  const int sr = tid >> 4, sc = (tid & 15) * 8, vst0 = v_st(sr, sc), vst1 = v_st(32 + sr, sc);
  const int vb0 = (int)(uintptr_t)V_lds + v_rd_base(lane);
  struct { bf16x8 vs0, vs1, ks0, ks1; } sr_[SDEPTH];
  const unsigned loff = (unsigned)(sr * LDK + sc) * 2u;
#define SLOAD(i, k0) do { const char* vb_ = (const char*)(Vh + (long)(k0) * LDK); const char* kb_ = (const char*)(Kh + (long)(k0) * LDK); \
    sr_[i].vs0 = *(const bf16x8*)(vb_ + loff); sr_[i].vs1 = *(const bf16x8*)(vb_ + 32 * LDK * 2 + loff); \
    sr_[i].ks0 = *(const bf16x8*)(kb_ + loff); sr_[i].ks1 = *(const bf16x8*)(kb_ + 32 * LDK * 2 + loff); } while (0)
#define SWRITE(b, i) do { *(bf16x8*)((char*)V_lds + (b) * SHM_V + vst0) = sr_[i].vs0;          \
    *(bf16x8*)((char*)V_lds + (b) * SHM_V + vst1) = sr_[i].vs1; int kc = sc * 2;               \
    *(bf16x8*)((char*)K_lds + (b) * SHM_K + KSWZ(sr, kc)) = sr_[i].ks0;                       \
    *(bf16x8*)((char*)K_lds + (b) * SHM_K + KSWZ(32 + sr, kc)) = sr_[i].ks1; } while (0)
#define SWAIT() do { if constexpr (SDEPTH == 2) asm volatile("s_waitcnt vmcnt(4)" ::: "memory"); else asm volatile("s_waitcnt vmcnt(0)" ::: "memory"); } while (0)
#define RESC(a) do { if (__any((a) < 1.f)) { if (hi == 0) al_l[r32] = (a); asm volatile("s_waitcnt lgkmcnt(0)" ::: "memory"); \
    for (int d = 0; d < 4; ++d) for (int r = 0; r < 16; ++r) o[d][r] *= al_l[crow(r, hi)]; } } while (0)
  f32x16 pA0, pA1, pB0, pB1; float mnA, mnB, alA, alB; bf16x8 pa0, pa1, pa2, pa3; const int NT = seq / KVBLK;
  constexpr int SE = 0, SO = SDEPTH - 1;
  SLOAD(SE, 0); asm volatile("s_waitcnt vmcnt(0)" ::: "memory"); SWRITE(0, SE); __syncthreads();
  qkt(pA0, pA1, K_lds, qr, r32, hi); partialSM(pA0, pA1, m_reg, mnA, alA);
  SLOAD(SO, KVBLK); if constexpr (SDEPTH == 2) { if (2 < NT) SLOAD(SE, 2 * KVBLK); }
  SWAIT(); SWRITE(1, SO); __syncthreads();
  for (int j = 1; j + 1 < NT; j += 2) {
    SBAR(); qkt(pB0, pB1, (bf16*)((char*)K_lds + SHM_K), qr, r32, hi);
    finishSM(pA0, pA1, alA, l_reg, pa0, pa1, pa2, pa3); SBAR();
    SLOAD(SO, (j + SDEPTH) * KVBLK); SBAR();
    pv_d0(o, vb0, pa0, pa1, pa2, pa3); partialSM(pB0, pB1, m_reg, mnB, alB);
    __syncthreads(); SWAIT(); SWRITE(0, SE);
    RESC(alB); __syncthreads();
    SBAR(); qkt(pA0, pA1, K_lds, qr, r32, hi);
    finishSM(pB0, pB1, alB, l_reg, pa0, pa1, pa2, pa3); SBAR();
    if (SDEPTH == 1 || j + 3 < NT) SLOAD(SE, (j + 1 + SDEPTH) * KVBLK); SBAR();
    pv_d0(o, vb0 + (int)SHM_V, pa0, pa1, pa2, pa3); partialSM(pA0, pA1, m_reg, mnA, alA);
    __syncthreads(); SWAIT(); SWRITE(1, SO);
    RESC(alA); __syncthreads();
  }
  SBAR(); qkt(pB0, pB1, (bf16*)((char*)K_lds + SHM_K), qr, r32, hi);
  finishSM(pA0, pA1, alA, l_reg, pa0, pa1, pa2, pa3); SBAR();
  pv_d0(o, vb0, pa0, pa1, pa2, pa3); partialSM(pB0, pB1, m_reg, mnB, alB);
  __syncthreads(); RESC(alB);
  finishSM(pB0, pB1, alB, l_reg, pa0, pa1, pa2, pa3); SBAR();
  pv_d0(o, vb0 + (int)SHM_V, pa0, pa1, pa2, pa3);
  if (hi == 0) li_l[r32] = l_reg; asm volatile("s_waitcnt lgkmcnt(0)" ::: "memory");
  float rli[16];
#pragma unroll
  for (int r = 0; r < 16; ++r) rli[r] = __builtin_amdgcn_rcpf(li_l[crow(r, hi)]);
  bf16_t* Ow = Ob + (long)(wid * QBLK) * LDO;
#pragma unroll
  for (int r = 0; r < 16; ++r) { int orow = crow(r, hi);
    for (int d0 = 0; d0 < 4; ++d0) Ow[(long)orow * LDO + d0 * 32 + r32] = (bf16_t)(cvtpk(o[d0][r] * rli[r], 0.f) & 0xffffu); }
#undef SLOAD
#undef SWRITE
#undef SWAIT
#undef RESC
}
#undef KSWZ
#undef SBAR
}

template <bool GLU> __device__ __forceinline__ void p0_transpose_item(const float* W, int K, int N, bf16_t* WT, LAS float* scr, int item, int lane) {
    const int nblk = N / 32, kb = item / nblk, nb = item % nblk, k0 = 64 * kb, n0 = 32 * nb;
    const int n0d = !GLU ? n0 : (n0 < FFN ? (n0 >> 7) * 256 + (n0 & 127) : ((n0 - FFN) >> 7) * 256 + 128 + ((n0 - FFN) & 127));
    float v[32];
    const float* wp0 = W + (size_t)(k0 + (lane >> 5)) * N + n0 + (lane & 31);
#pragma unroll
    for (int i = 0; i < 32; ++i) v[i] = wp0[(size_t)(2 * i) * N];
#pragma unroll
    for (int i = 0; i < 32; ++i) scr[(2 * i + (lane >> 5)) * 33 + (lane & 31)] = v[i];
    asm volatile("s_waitcnt lgkmcnt(0)" ::: "memory");
    const int c = lane & 7;
#pragma unroll
    for (int j = 0; j < 4; ++j) { const int n = (lane >> 3) + 8 * j; const LAS float* s = scr + (8 * c) * 33 + n;
        u32x4 o; o.x = cvt_pk_bf16(s[0 * 33], s[1 * 33]); o.y = cvt_pk_bf16(s[2 * 33], s[3 * 33]); o.z = cvt_pk_bf16(s[4 * 33], s[5 * 33]); o.w = cvt_pk_bf16(s[6 * 33], s[7 * 33]);
        *(u32x4*)(WT + (size_t)(n0d + n) * K + k0 + 8 * c) = o; }
    asm volatile("s_waitcnt lgkmcnt(0)" ::: "memory");
}

__device__ __forceinline__ void phase0(KP pp, LAS unsigned char* lds, int G, const int tid, const int bid) {
    const int lane = tid & 63, wave = tid >> 6;
    unsigned char* ws = pp->ws;
    LAS float* sv = (LAS float*)lds;
    for (int i = tid; i < 9 * DM; i += NTHREADS) { const int r = i / DM, k = i % DM; const float v = r < 8 ? pp->in[1][r * DM + k] : pp->in[3][k];
        sv[i] = v / (1.f + __expf(-v)); }
    __syncthreads();
    {
        const float* wmod = pp->in[4]; float* part = (float*)(ws + WS_MODP);
        LAS float* red = (LAS float*)(lds + 9 * DM * 4);
        const int grp = tid >> 7, t7 = tid & 127;
        for (int it = bid; it < 768; it += G) {
            const int L = it / 384, rem = it % 384, cb = rem % 24, kc = rem / 24;
            const int col = cb * 512 + t7 * 4, kb = kc * 128 + grp * 32;
            f32x4 acc[9];
#pragma unroll
            for (int r = 0; r < 9; ++r) acc[r] = (f32x4){0.f, 0.f, 0.f, 0.f};
            const float* wp = wmod + ((size_t)L * DM + kb) * NMODC + col;
#pragma unroll 8
            for (int k = 0; k < 32; ++k) { const f32x4 w = *(const f32x4*)(wp + (size_t)k * NMODC);
#pragma unroll
                for (int r = 0; r < 9; ++r) acc[r] += w * sv[r * DM + kb + k]; }
            if (grp > 0) {
#pragma unroll
                for (int r = 0; r < 9; ++r) *(LAS f32x4*)(red + ((grp - 1) * 9 + r) * 512 + t7 * 4) = acc[r];
            }
            __syncthreads();
            if (grp == 0) {
#pragma unroll
                for (int r = 0; r < 9; ++r) { f32x4 a = acc[r];
#pragma unroll
                    for (int g2 = 0; g2 < 3; ++g2) a += *(const LAS f32x4*)(red + (g2 * 9 + r) * 512 + t7 * 4);
                    *(f32x4*)(part + ((size_t)(kc * 2 + L) * 9 + r) * NMODC + col) = a; }
            }
            __syncthreads();
        }
    }
    __syncthreads();
    {
        LAS float* scr = (LAS float*)(lds + wave * 16384);
        const int gw = bid * NWAVES + wave, NGW = G * NWAVES;
        constexpr int I_IN = (DM / 64) * (INW / 32), I_OUT = (DM / 64) * (DM / 32), I_UP = (DM / 64) * (UPW / 32), I_DN = (FFN / 64) * (DM / 32);
        constexpr int PER = I_IN + I_OUT + I_UP + I_DN;
        for (int it = gw; it < 2 * PER; it += NGW) {
            const int L = it / PER; int r = it % PER;
            if (r < I_IN) { p0_transpose_item<false>(pp->in[10] + (size_t)L * DM * INW, DM, INW, (bf16_t*)(ws + WS_WIN) + (size_t)L * INW * DM, scr, r, lane); continue; } r -= I_IN;
            if (r < I_OUT) { p0_transpose_item<false>(pp->in[16] + (size_t)L * DM * DM, DM, DM, (bf16_t*)(ws + WS_WOUT) + (size_t)L * DM * DM, scr, r, lane); continue; } r -= I_OUT;
            if (r < I_UP) { p0_transpose_item<true>(pp->in[17] + (size_t)L * DM * UPW, DM, UPW, (bf16_t*)(ws + WS_WUP) + (size_t)L * UPW * DM, scr, r, lane); continue; } r -= I_UP;
            p0_transpose_item<false>(pp->in[20] + (size_t)L * FFN * DM, FFN, DM, (bf16_t*)(ws + WS_WDN) + (size_t)L * DM * FFN, scr, r, lane);
        }
    }
    __syncthreads();
    {
        const int gt = bid * NTHREADS + tid, NGT = G * NTHREADS;
        bf16_t* d2048 = (bf16_t*)(ws + WS_D2048);
        for (int it = gt; it < 2048 * 2048 / 8; it += NGT) {
            const int r = it / 256, t0 = (it % 256) * 8, k = r & 1023; float v[8];
#pragma unroll
            for (int e = 0; e < 8; ++e) { const float rev = (float)((k * (t0 + e)) & 2047) * (1.f / 2048.f);
                v[e] = r < 1024 ? __builtin_amdgcn_cosf(rev) : __builtin_amdgcn_sinf(rev); }
            u32x4 o; o.x = cvt_pk_bf16(v[0], v[1]); o.y = cvt_pk_bf16(v[2], v[3]); o.z = cvt_pk_bf16(v[4], v[5]); o.w = cvt_pk_bf16(v[6], v[7]);
            *(u32x4*)(d2048 + (size_t)r * 2048 + t0) = o;
        }
        bf16_t* d256 = (bf16_t*)(ws + WS_D256);
        for (int it = gt; it < 256 * 512 / 8; it += NGT) {
            const int k = it / 64, tt0 = (it % 64) * 8; float v[8];
#pragma unroll
            for (int e = 0; e < 8; ++e) { const int tt = tt0 + e, t = tt & 255; const float rev = (float)((k * t) & 255) * (1.f / 256.f);
                v[e] = tt < 256 ? __builtin_amdgcn_cosf(rev) : -__builtin_amdgcn_sinf(rev); }
            u32x4 o; o.x = cvt_pk_bf16(v[0], v[1]); o.y = cvt_pk_bf16(v[2], v[3]); o.z = cvt_pk_bf16(v[4], v[5]); o.w = cvt_pk_bf16(v[6], v[7]);
            *(u32x4*)(d256 + (size_t)k * 512 + tt0) = o;
        }
        LAS float* tab = (LAS float*)lds;
        LAS float* wl = (LAS float*)lds + 256;
        const float* wf = pp->in[13]; bf16_t* cws = (bf16_t*)(ws + WS_CWS);
        for (int it = bid; it < 256; it += G) {
            const int lg = it >> 4, half = (it >> 3) & 1, cblk = it & 7;
            __syncthreads();
            if (tid < 128) { const float rev = (float)tid * (1.f / 128.f); tab[tid] = __builtin_amdgcn_cosf(rev); tab[128 + tid] = __builtin_amdgcn_sinf(rev); }
#pragma unroll
            for (int i = 0; i < 8; ++i) *(LAS f32x4*)(wl + (i * 512 + tid) * 4) = *(const f32x4*)(wf + (size_t)lg * 16384 + (i * 512 + tid) * 4);
            __syncthreads();
            const int d = tid & 127, c0 = cblk * 16 + (tid >> 7) * 4;
            const LAS float* tb = tab + half * 128;
            float s0 = 0.f, s1 = 0.f, s2 = 0.f, s3 = 0.f;
#pragma unroll 8
            for (int l = 0; l < 128; ++l) { const float w = wl[l * 128 + d];
                s0 += tb[(l * c0) & 127] * w; s1 += tb[(l * (c0 + 1)) & 127] * w; s2 += tb[(l * (c0 + 2)) & 127] * w; s3 += tb[(l * (c0 + 3)) & 127] * w; }
            u32x2 o; o.x = cvt_pk_bf16(s0, s1); o.y = cvt_pk_bf16(s2, s3);
            *(u32x2*)(cws + ((size_t)lg * 256 + half * 128 + d) * 128 + c0) = o;
        }
    }
}

__device__ __forceinline__ void phase0b(KP pp, int G, const int tid, const int bid) {
    const int gt = bid * NTHREADS + tid, NGT = G * NTHREADS;
    const float* part = (const float*)(pp->ws + WS_MODP); float* mod = (float*)(pp->ws + WS_MOD); const float* bmod = pp->in[5];
    for (int i = gt; i < 2 * 9 * NMODC; i += NGT) {
        const int col = i % NMODC, L = i / (9 * NMODC);
        float s = bmod[L * NMODC + col];
#pragma unroll
        for (int kc = 0; kc < 16; ++kc) s += part[(size_t)kc * 2 * 9 * NMODC + i];
        mod[i] = s;
    }
}

struct RM {
    int row0, nrows;
    const float* srcL; const float* srcC; const bf16_t* srcB; float* dstF; bf16_t* dstB;
    const bf16_t* y; const bf16_t* ysplit; const float* gate; const float* gpost;
    bf16_t* H; const float* gpre; const float* shift; const float* scale;
};
__device__ __forceinline__ void resid_mod(const RM& a, int G, const int tid, const int bid) {
    const int lane = tid & 63, gw = bid * NWAVES + (tid >> 6), NGW = G * NWAVES;
    for (int row = a.row0 + gw; row < a.nrows; row += NGW) {
        const bool lat = row < ML; const int mr = lat ? row / SEQ : 8;
        f32x4 x[8];
        if (a.srcB) {
            u32x2 w[8];
#pragma unroll
            for (int j = 0; j < 8; ++j) w[j] = *(const u32x2*)(a.srcB + (size_t)row * DM + j * 256 + lane * 4);
#pragma unroll
            for (int j = 0; j < 8; ++j) x[j] = (f32x4){bf_lo(w[j].x), bf_hi(w[j].x), bf_lo(w[j].y), bf_hi(w[j].y)};
        } else {
            const float* src = lat ? a.srcL + (size_t)row * DM : a.srcC + (size_t)(row - ML) * DM;
#pragma unroll
            for (int j = 0; j < 8; ++j) x[j] = *(const f32x4*)(src + j * 256 + lane * 4);
        }
        if (a.y) {
            const bf16_t* yr = a.y + (size_t)row * DM; f32x4 yv[8]; float ss = 0.f;
            if (lat || !a.ysplit) {
                u32x2 w[8];
#pragma unroll
                for (int j = 0; j < 8; ++j) w[j] = *(const u32x2*)(yr + j * 256 + lane * 4);
#pragma unroll
                for (int j = 0; j < 8; ++j) yv[j] = (f32x4){bf_lo(w[j].x), bf_hi(w[j].x), bf_lo(w[j].y), bf_hi(w[j].y)};
            } else {
#pragma unroll
                for (int j = 0; j < 8; ++j) yv[j] = (f32x4){0.f, 0.f, 0.f, 0.f};
#pragma unroll
                for (int ks = 0; ks < 4; ++ks) {
                    u32x2 w[8];
#pragma unroll
                    for (int j = 0; j < 8; ++j) w[j] = *(const u32x2*)(a.ysplit + ((size_t)ks * MC + (row - ML)) * DM + j * 256 + lane * 4);
#pragma unroll
                    for (int j = 0; j < 8; ++j) yv[j] += (f32x4){bf_lo(w[j].x), bf_hi(w[j].x), bf_lo(w[j].y), bf_hi(w[j].y)};
                }
            }
#pragma unroll
            for (int j = 0; j < 8; ++j) ss += (yv[j].x * yv[j].x + yv[j].y * yv[j].y) + (yv[j].z * yv[j].z + yv[j].w * yv[j].w);
            const float rstd = __builtin_amdgcn_rsqf(wave_sum(ss) * (1.f / DM) + EPS);
            const float* gt = a.gate + (size_t)mr * NMODC;
#pragma unroll
            for (int j = 0; j < 8; ++j) { const int e = j * 256 + lane * 4; const f32x4 g = *(const f32x4*)(gt + e), gp = *(const f32x4*)(a.gpost + e);
                x[j] = x[j] + g * (yv[j] * rstd * gp);
                if (a.dstB) { u32x2 w; w.x = cvt_pk_bf16(x[j].x, x[j].y); w.y = cvt_pk_bf16(x[j].z, x[j].w); *(u32x2*)(a.dstB + (size_t)row * DM + e) = w;
                    x[j] = (f32x4){bf_lo(w.x), bf_hi(w.x), bf_lo(w.y), bf_hi(w.y)}; }
                else *(f32x4*)(a.dstF + (size_t)row * DM + e) = x[j]; }
        }
        if (a.H) {
            float ss = 0.f;
#pragma unroll
            for (int j = 0; j < 8; ++j) ss += (x[j].x * x[j].x + x[j].y * x[j].y) + (x[j].z * x[j].z + x[j].w * x[j].w);
            const float rstd = __builtin_amdgcn_rsqf(wave_sum(ss) * (1.f / DM) + EPS);
            const float* sh = a.shift + (size_t)mr * NMODC; const float* scl = a.scale + (size_t)mr * NMODC; bf16_t* hr = a.H + (size_t)row * DM;
#pragma unroll
            for (int j = 0; j < 8; ++j) { const int e = j * 256 + lane * 4; const f32x4 g = *(const f32x4*)(a.gpre + e), s1 = *(const f32x4*)(scl + e), s0 = *(const f32x4*)(sh + e);
                const f32x4 h = (x[j] * rstd * g) * (s1 + 1.f) + s0; u32x2 w; w.x = cvt_pk_bf16(h.x, h.y); w.y = cvt_pk_bf16(h.z, h.w);
                *(u32x2*)(hr + e) = w; }
        }
    }
}

__device__ __forceinline__ void merge_phase(const bf16_t* attO, const bf16_t* fourO, const float* nyq, const float* gattn, const float* gfour, bf16_t* Y, int nrows, int G, const int tid, const int bid) {
    const int lane = tid & 63, gw = bid * NWAVES + (tid >> 6), NGW = G * NWAVES;
    for (int row = gw; row < nrows; row += NGW) {
        f32x4 a[4], f[4]; float sa = 0.f, sf = 0.f;
#pragma unroll
        for (int j = 0; j < 4; ++j) { const u32x2 w = *(const u32x2*)(attO + (size_t)row * 1024 + j * 256 + lane * 4); a[j] = (f32x4){bf_lo(w.x), bf_hi(w.x), bf_lo(w.y), bf_hi(w.y)}; }
        if (row < ML) {
            const int b = row >> 11, k = row & 2047, kk = k <= 1024 ? k : 2048 - k; const float sg = k <= 1024 ? -1.f : 1.f;
            const bool hasS = (kk != 0 && kk != 1024);
            const bf16_t* crow = fourO + ((size_t)b * 2048 + (kk < 1024 ? kk : 0)) * 1024; const bf16_t* srow = fourO + ((size_t)b * 2048 + 1024 + (hasS ? kk : 0)) * 1024;
            u32x2 wc[4], wsn[4];
#pragma unroll
            for (int j = 0; j < 4; ++j) { wc[j] = *(const u32x2*)(crow + j * 256 + lane * 4); wsn[j] = *(const u32x2*)(srow + j * 256 + lane * 4); }
#pragma unroll
            for (int j = 0; j < 4; ++j) { f32x4 c = (f32x4){bf_lo(wc[j].x), bf_hi(wc[j].x), bf_lo(wc[j].y), bf_hi(wc[j].y)};
                if (kk == 1024) c = *(const f32x4*)(nyq + b * 1024 + j * 256 + lane * 4);
                const f32x4 sv = (f32x4){bf_lo(wsn[j].x), bf_hi(wsn[j].x), bf_lo(wsn[j].y), bf_hi(wsn[j].y)};
                f[j] = hasS ? c + sv * sg : c; }
        } else {
#pragma unroll
            for (int j = 0; j < 4; ++j) { const u32x2 w = *(const u32x2*)(fourO + (size_t)row * 1024 + j * 256 + lane * 4); f[j] = (f32x4){bf_lo(w.x), bf_hi(w.x), bf_lo(w.y), bf_hi(w.y)}; }
        }
#pragma unroll
        for (int j = 0; j < 4; ++j) {
            sa += (a[j].x * a[j].x + a[j].y * a[j].y) + (a[j].z * a[j].z + a[j].w * a[j].w);
            sf += (f[j].x * f[j].x + f[j].y * f[j].y) + (f[j].z * f[j].z + f[j].w * f[j].w); }
        const float ra = __builtin_amdgcn_rsqf(wave_sum(sa) * (1.f / 1024.f) + EPS), rf = __builtin_amdgcn_rsqf(wave_sum(sf) * (1.f / 1024.f) + EPS);
        bf16_t* yr = Y + (size_t)row * DM;
#pragma unroll
        for (int j = 0; j < 4; ++j) { const int e = j * 256 + lane * 4; const f32x4 ga = *(const f32x4*)(gattn + e), gf = *(const f32x4*)(gfour + e);
            const f32x4 va = a[j] * ra * ga, vf = f[j] * rf * gf; u32x2 w; w.x = cvt_pk_bf16(va.x, va.y); w.y = cvt_pk_bf16(va.z, va.w); *(u32x2*)(yr + e) = w;
            w.x = cvt_pk_bf16(vf.x, vf.y); w.y = cvt_pk_bf16(vf.z, vf.w); *(u32x2*)(yr + 1024 + e) = w; }
    }
}

__device__ __forceinline__ void nyq_phase(const bf16_t* YTL, float* nyq, int G, const int tid, const int bid) {
    const int lane = tid & 63, gw = bid * NWAVES + (tid >> 6), NGW = G * NWAVES;
    for (int idx = gw; idx < NB * 1024; idx += NGW) {
        const int b = idx >> 10, ch = idx & 1023;
        const bf16_t* r = YTL + ((size_t)(b * 2) * 1024 + ch) * SEQ + lane * 8;
        float s = 0.f;
#pragma unroll
        for (int i = 0; i < 4; ++i) { const u32x4 w = *(const u32x4*)(r + i * 512);
            s += (bf_lo(w.x) - bf_hi(w.x)) + (bf_lo(w.y) - bf_hi(w.y)) + (bf_lo(w.z) - bf_hi(w.z)) + (bf_lo(w.w) - bf_hi(w.w)); }
        s = wave_sum(s);
        if (lane == 0) nyq[idx] = s * (1.f / 512.f);
    }
}

__device__ __forceinline__ void glufix_phase(bf16_t* Aact, const float* zp, const float* gv, const float* vv, const float* cw, int nrows, int G, const int tid, const int bid) {
    const int gt = bid * NTHREADS + tid, NGT = G * NTHREADS;
    constexpr int NC4 = FFN / 4;
    const int nitems = (nrows / 256) * 4 * NC4;
    for (int it = gt; it < nitems; it += NGT) {
        const int brow = it / NC4, col = (it % NC4) * 4, k = brow & 3, pm = brow >> 2;
        const int r = pm * 256 + (k == 0 ? 0 : k == 1 ? 127 : k == 2 ? 128 : 255);
        const int slen = r < ML ? SEQ : CTXL;
        f32x4 miss = (f32x4){0.f, 0.f, 0.f, 0.f}; const float* wsel = cw + ((k & 1) ? 2 * FFN : 0) + col;
        if (k == 0) { if ((r % slen) != 0) miss = *(const f32x4*)(gv + (size_t)(brow - 1) * FFN + col); }
        else if (k == 3) { if (((r + 1) % slen) != 0) miss = *(const f32x4*)(gv + (size_t)(brow + 1) * FFN + col); }
        else miss = *(const f32x4*)(gv + (size_t)(k == 1 ? brow + 1 : brow - 1) * FFN + col);
        const f32x4 z = *(const f32x4*)(zp + (size_t)brow * FFN + col) + miss * *(const f32x4*)wsel, v = *(const f32x4*)(vv + (size_t)brow * FFN + col);
        u32x2 w; w.x = cvt_pk_bf16(gelu_tanh(z.x) * v.x, gelu_tanh(z.y) * v.y); w.y = cvt_pk_bf16(gelu_tanh(z.z) * v.z, gelu_tanh(z.w) * v.w);
        *(u32x2*)(Aact + (size_t)r * FFN + col) = w;
    }
}

#define XB_TMO      128
#define XB_XCNT(j)  (256  + 64 * (j))
#define XB_XSUB(j)  (1280 + 64 * (j))
#define XB_XGEN(j)  (2304 + 64 * (j))
#define XB_TOP      3328
#define XB_TOPGEN   3392
#define XCD_BAR_WORDS 3456
#define XB_SPIN_CAP (1u << 18)
__device__ __forceinline__ unsigned xb_ld(unsigned* p)              { return __hip_atomic_load(p, __ATOMIC_RELAXED, __HIP_MEMORY_SCOPE_AGENT); }
__device__ __forceinline__ unsigned xb_add(unsigned* p, unsigned v) { return __hip_atomic_fetch_add(p, v, __ATOMIC_RELAXED, __HIP_MEMORY_SCOPE_AGENT); }
__device__ __forceinline__ unsigned xb_xcc_id() { return (unsigned)__builtin_amdgcn_s_getreg((3 << 11) | 20) & 0xFu; }
#define XB_SPIN(cond, bar) do { unsigned _sp = 0; while (cond) { __builtin_amdgcn_s_sleep(1); \
    if ((++_sp & 255u) == 0u) { if (xb_ld(&(bar)[XB_TMO])) break; if (_sp > XB_SPIN_CAP) { atomicAdd(&(bar)[XB_TMO], 1u); break; } } } } while (0)
struct XcdBarrier { unsigned* bar; unsigned x; volatile LAS unsigned* st; };
__device__ __forceinline__ void xcd_barrier_complete(unsigned* bar, unsigned x, unsigned& nloc, unsigned& nx) {
    const unsigned G = gridDim.x * gridDim.y * gridDim.z;
    unsigned sum, cnt, mine, sp = 0u;
    for (;;) {
        sum = 0u; cnt = 0u; mine = 0u;
#pragma unroll
        for (unsigned j = 0; j < 16; ++j) { const unsigned c = xb_ld(&bar[XB_XCNT(j)]); sum += c; cnt += (c > 0u) ? 1u : 0u; mine = (j == x) ? c : mine; }
        if (sum == G) break;
        __builtin_amdgcn_s_sleep(1);
        if ((++sp & 255u) == 0u) { if (xb_ld(&bar[XB_TMO])) break; if (sp > XB_SPIN_CAP) { atomicAdd(&bar[XB_TMO], 1u); break; } }
    }
    nloc = mine > 0u ? mine : 1u; nx = cnt > 0u ? cnt : 1u;
}
__device__ __forceinline__ void xcd_barrier(const XcdBarrier& b, const int tid) {
    asm volatile("s_waitcnt vmcnt(0)" ::: "memory");
    __syncthreads();
    if (tid == 0) {
        unsigned* bar = b.bar;
        __builtin_amdgcn_s_waitcnt(0);
        unsigned nloc = b.st[0], nx = b.st[1];
        if (nloc == 0u) { xcd_barrier_complete(bar, b.x, nloc, nx); b.st[0] = nloc; b.st[1] = nx; }
        const unsigned old = xb_add(&bar[XB_XSUB(b.x)], 1u);
        const unsigned gen = old / nloc;
        if (old + 1u == (gen + 1u) * nloc) {
            __builtin_amdgcn_fence(__ATOMIC_RELEASE, "agent");
            asm volatile("s_waitcnt vmcnt(0)" ::: "memory");
            const unsigned og = xb_add(&bar[XB_TOP], 1u);
            const unsigned tg = og / nx;
            if (og + 1u == (tg + 1u) * nx) xb_add(&bar[XB_TOPGEN], 1u);
            else XB_SPIN(xb_ld(&bar[XB_TOPGEN]) == tg, bar);
            __builtin_amdgcn_fence(__ATOMIC_ACQUIRE, "agent");
            xb_add(&bar[XB_XGEN(b.x)], 1u);
            asm volatile("s_waitcnt vmcnt(0)" ::: "memory");
        } else {
            XB_SPIN(xb_ld(&bar[XB_XGEN(b.x)]) == gen, bar);
            __builtin_amdgcn_fence(__ATOMIC_ACQUIRE, "agent");
            asm volatile("s_waitcnt vmcnt(0)" ::: "memory");
        }
    }
    __syncthreads();
}

enum { ST_P0 = 0, ST_P0B, ST_RM0, ST_G1, ST_QK, ST_ATT, ST_MRG, ST_G2, ST_RM1, ST_G3, ST_CGLU, ST_G4, ST_RM2 };

__global__ void __launch_bounds__(NTHREADS, 2) fwd_megakernel(Params p_arg) {
    (void)p_arg;
    extern __shared__ __attribute__((aligned(16))) unsigned char lds_raw[];
    cg::grid_group grid = cg::this_grid();
    const int G_u = gridDim.x;
    const int wv_u = __builtin_amdgcn_readfirstlane((int)(threadIdx.x >> 6));
    {
        volatile LAS unsigned* st0 = (volatile LAS unsigned*)((LAS unsigned char*)lds_raw + 131072);
        if (threadIdx.x < 2) st0[threadIdx.x] = 0u;
        __syncthreads();
        if (threadIdx.x == 0) { KP pp0 = (KP)__builtin_amdgcn_kernarg_segment_ptr(); (void)xb_add((unsigned*)pp0->ws + XB_XCNT(xb_xcc_id()), 1u); }
    }

    constexpr int NSTEPS = 3 + 10 * DEPTH;
#pragma unroll 1
    for (int step = 0; step < NSTEPS; ++step) {
#define FRESH_TID() ({ unsigned zv_; asm volatile("v_mov_b32 %0, 0" : "=v"(zv_)); wv_u * 64 + (int)__builtin_amdgcn_mbcnt_hi(~0u, __builtin_amdgcn_mbcnt_lo(~0u, zv_)); })
        const int tid = FRESH_TID();
        int bid = blockIdx.x; asm volatile("" : "+s"(bid));
        int G = G_u; asm volatile("" : "+s"(G));
        KP pp = (KP)__builtin_amdgcn_kernarg_segment_ptr(); asm volatile("" : "+s"(pp));
        unsigned char* ws = pp->ws;
        LAS unsigned char* lds = (LAS unsigned char*)lds_raw;
        float* mod = (float*)(ws + WS_MOD);
        bf16_t* Hb = (bf16_t*)(ws + WS_H); bf16_t* MIX = (bf16_t*)(ws + WS_MIX); bf16_t* U = (bf16_t*)(ws + WS_R1);
        bf16_t* Pb = (bf16_t*)(ws + WS_P); bf16_t* Qn = (bf16_t*)(ws + WS_QN); bf16_t* Kall = (bf16_t*)(ws + WS_KALL); bf16_t* Vall = (bf16_t*)(ws + WS_VALL);
        bf16_t* YTL = (bf16_t*)(ws + WS_YTL); bf16_t* YTC = (bf16_t*)(ws + WS_YTC); bf16_t* attO = (bf16_t*)(ws + WS_ATTO); bf16_t* fourO = (bf16_t*)(ws + WS_FOURO);
        bf16_t* XS = (bf16_t*)(ws + WS_XS); bf16_t* YPART = (bf16_t*)(ws + WS_YPART);
        const int kind = step < 3 ? step : 3 + (step - 3) % 10;
        const int L = step < 3 ? 0 : (step - 3) / 10;
        const bool lastL = (L == DEPTH - 1);
        const int mrows = lastL ? ML : MT;
        const float* modL = mod + (size_t)L * 9 * NMODC;
        if ((kind == ST_RM1 || kind == ST_RM2) && lastL) continue;
        int njobs = 0;
        if (kind == ST_P0) phase0(pp, lds, G, tid, bid);
        else if (kind == ST_P0B) phase0b(pp, G, tid, bid);
        else if (kind == ST_RM0 || kind == ST_RM1 || kind == ST_RM2) {
            RM a;
            a.row0 = 0; a.srcL = pp->in[0]; a.srcC = pp->in[2]; a.srcB = nullptr; a.dstF = nullptr; a.dstB = nullptr; a.y = nullptr; a.ysplit = nullptr; a.gate = nullptr; a.gpost = nullptr;
            if (kind == ST_RM0) { a.nrows = MT; a.H = Hb; a.gpre = pp->in[6]; a.shift = mod; a.scale = mod + DM; }
            else if (kind == ST_RM1) { a.row0 = ML; a.nrows = MT; a.dstB = XS; a.y = MIX; a.ysplit = YPART; a.gate = modL + 2 * DM; a.gpost = pp->in[7] + L * DM;
                a.H = MIX; a.gpre = pp->in[8] + L * DM; a.shift = modL + 3 * DM; a.scale = modL + 4 * DM; }
            else { a.row0 = ML; a.nrows = MT; a.srcB = XS; a.dstB = XS; a.y = MIX; a.ysplit = YPART; a.gate = modL + 5 * DM; a.gpost = pp->in[9] + L * DM;
                a.H = Hb; a.gpre = pp->in[6] + (L + 1) * DM; a.shift = modL + 9 * NMODC; a.scale = modL + 9 * NMODC + DM; }
            resid_mod(a, G, tid, bid);
        }
        else if (kind == ST_QK) { njobs = 1; }
        else if (kind == ST_MRG) merge_phase(attO, fourO, (const float*)(ws + WS_NYQ), pp->in[14] + L * 1024, pp->in[15] + L * 1024, Hb, mrows, G, tid, bid);
        else if (kind == ST_CGLU) glufix_phase(U, (const float*)(ws + WS_ZP), (const float*)(ws + WS_GV), (const float*)(ws + WS_VV), pp->in[18] + (size_t)L * 3 * FFN, mrows, G, tid, bid);
        else if (kind == ST_ATT) {
            const int nunits = lastL ? 512 : 576;
            for (int u = bid; u < nunits; u += G) {
                const att::bf16 *Qb, *Kh, *Vh; bf16_t* Ob; int seq;
                if (u < 512) {
                    int pair, j;
                    if (G == 256) { const int i = u >> 8, cc = u & 255; pair = i * 8 + (cc & 7); j = cc >> 3; } else { pair = u >> 5; j = u & 31; }
                    const int b = pair >> 1, kvh = pair & 1, gq = j >> 3, qb = j & 7, h = kvh * 4 + gq;
                    const size_t qrow = (size_t)b * SEQ + qb * 256;
                    Qb = (const att::bf16*)(Qn + qrow * 1024 + h * 128); Ob = attO + qrow * 1024 + h * 128;
                    Kh = (const att::bf16*)(Kall + (size_t)b * SKV * 256 + kvh * 128); Vh = (const att::bf16*)(Vall + (size_t)b * SKV * 256 + kvh * 128); seq = SKV;
                } else {
                    const int v = u - 512, b = v >> 3, h = v & 7;
                    const size_t qrow = (size_t)ML + b * CTXL;
                    Qb = (const att::bf16*)(Qn + qrow * 1024 + h * 128); Ob = attO + qrow * 1024 + h * 128;
                    Kh = (const att::bf16*)(Kall + ((size_t)b * SKV + SEQ) * 256 + (h >> 2) * 128); Vh = (const att::bf16*)(Vall + ((size_t)b * SKV + SEQ) * 256 + (h >> 2) * 128); seq = CTXL;
                }
                att::attn_dense_body(Qb, Kh, Vh, Ob, seq, (char*)lds_raw, tid);
                __syncthreads();
            }
            nyq_phase(YTL, (float*)(ws + WS_NYQ), G, tid, bid);
            njobs = lastL ? 1 : 2;
        }
        else njobs = ((kind == ST_G2 || kind == ST_G4) && !lastL) ? 2 : 1;

        if (kind == ST_G1) {
            const int ts = FRESH_TID();
            if (ts < 256) { const unsigned ti = (unsigned)ts & 127u; const float* qn_ = pp->in[11] + L * 128; const float* kn_ = pp->in[12] + L * 128;
                float nv; if (ts < 128) nv = qn_[ti]; else nv = kn_[ti];
                ((LAS float*)(lds + CWL_OFF))[ts] = nv; }
        }
        for (int j = 0; j < njobs; ++j) {
            const int tj = FRESH_TID();
            pg8::Job J; J.ksplit = 1; J.ostride_ks = 0; J.amod = 1 << 30; J.bdiv = 1 << 30; J.bstride_m = 0; J.mode = 0; J.scale = 1.f; J.O2 = nullptr; J.pp = pp; J.ws = ws; J.L = L; J.which = 0;
            if (kind == ST_G1) { J.A = Hb; J.lda = DM; J.B = (const bf16_t*)(ws + WS_WIN) + (size_t)L * INW * DM; J.ldb = DM; J.K = DM; J.nM = MT / 256; J.nN = INW / 256; J.O = Pb; J.ldc = INW; J.mode = 3; }
            else if (kind == ST_QK) { J.A = (const bf16_t*)(ws + WS_CWS) + (size_t)L * 8 * 256 * 128; J.lda = 128; J.B = Pb + QKVW; J.ldb = INW; J.K = 128; J.nM = 8; J.nN = mrows / 256;
                J.bdiv = 1; J.bstride_m = 128; J.O = YTL; J.O2 = YTC; J.ldc = 0; J.mode = 1; }
            else if (kind == ST_ATT) {
                if (j == 0) { J.A = (const bf16_t*)(ws + WS_D2048); J.lda = 2048; J.amod = 8; J.B = YTL; J.ldb = 2048; J.bdiv = 4; J.bstride_m = (long)1024 * 2048; J.K = 2048; J.nM = 64; J.nN = 4;
                    J.O = fourO; J.ldc = 1024; J.scale = 1.f / 512.f; }
                else { J.A = (const bf16_t*)(ws + WS_D256); J.lda = 512; J.amod = 1; J.B = YTC; J.ldb = 512; J.bdiv = 1; J.bstride_m = (long)1024 * 512; J.K = 512; J.nM = 8; J.nN = 4;
                    J.O = fourO + (size_t)ML * 1024; J.ldc = 1024; J.scale = 0.005524271728019903f; }
            }
            else if (kind == ST_G2) { J.A = Hb; J.lda = DM; J.B = (const bf16_t*)(ws + WS_WOUT) + (size_t)L * DM * DM; J.ldb = DM; J.K = DM; J.nM = ML / 256; J.nN = DM / 256; J.O = MIX; J.ldc = DM;
                if (j == 1) { J.A = Hb + (size_t)ML * DM; J.nM = MC / 256; J.ksplit = 4; J.K = DM / 4; J.O = YPART; J.ostride_ks = (long)MC * DM; }
                else { J.mode = 5; J.which = 0; } }
            else if (kind == ST_G3) { J.A = MIX; J.lda = DM; J.B = (const bf16_t*)(ws + WS_WUP) + (size_t)L * UPW * DM; J.ldb = DM; J.K = DM; J.nM = mrows / 256; J.nN = UPW / 256; J.O = U; J.ldc = FFN; J.mode = 2; }
            else { J.A = U; J.lda = FFN; J.B = (const bf16_t*)(ws + WS_WDN) + (size_t)L * DM * FFN; J.ldb = FFN; J.K = FFN; J.nM = ML / 256; J.nN = DM / 256; J.O = MIX; J.ldc = DM;
                if (j == 1) { J.A = U + (size_t)ML * FFN; J.nM = MC / 256; J.ksplit = 4; J.K = FFN / 4; J.O = YPART; J.ostride_ks = (long)MC * DM; }
                else { J.mode = lastL ? 4 : 5; J.which = 1; } }
            J.astride = (long)256 * J.lda; J.bstride_n = (long)256 * J.ldb;
            pg8::StaticOrder S; S.init(J.nM, J.nN * J.ksplit, G, bid); S.panel = (J.mode == 4 || J.mode == 5);
            __syncthreads();
            pg8::gemm_phase(lds, J, S, tj);
        }
        if (gridDim.y == 0x7fff) grid.sync();
        { XcdBarrier xb; xb.bar = (unsigned*)ws; xb.x = xb_xcc_id(); xb.st = (volatile LAS unsigned*)(lds + 131072); xcd_barrier(xb, FRESH_TID()); }
    }
}

extern "C" void kernel_launch(void* const* d_in, const int* in_sizes, int n_in, void* d_out, int out_size, void* d_ws, size_t ws_size, hipStream_t stream) {
    static int grid = 0;
    if (grid == 0) {
        if (n_in != 21 || out_size != ML * DM || ws_size < WS_END) { fprintf(stderr, "kernel_launch: unexpected shapes: n_in %d out %d ws %zu (need %zu)\n", n_in, out_size, ws_size, (size_t)WS_END); grid = -1; return; }
        int dev = 0, cus = 0, per_cu = 0;
        (void)hipGetDevice(&dev); (void)hipDeviceGetAttribute(&cus, hipDeviceAttributeMultiprocessorCount, dev);
        if (hipFuncSetAttribute((const void*)fwd_megakernel, hipFuncAttributeMaxDynamicSharedMemorySize, LDS_BYTES) != hipSuccess) { fprintf(stderr, "kernel_launch: hipFuncSetAttribute failed\n"); grid = -1; return; }
        if (hipOccupancyMaxActiveBlocksPerMultiprocessor(&per_cu, (const void*)fwd_megakernel, NTHREADS, LDS_BYTES) != hipSuccess || per_cu < 1) { fprintf(stderr, "kernel_launch: occupancy query gave %d\n", per_cu); (void)hipGetLastError(); per_cu = 1; }
        grid = cus;
        if (grid > cus * per_cu) grid = cus * per_cu;
    }
    if (grid < 0) return;
    if (hipMemsetAsync(d_ws, 0, 262144, stream) != hipSuccess) { fprintf(stderr, "kernel_launch: hipMemsetAsync failed\n"); return; }
    Params p{};
    for (int i = 0; i < 21; ++i) p.in[i] = (const float*)d_in[i];
    p.out = (float*)d_out; p.ws = (unsigned char*)d_ws;
    void* args[] = {&p};
    hipError_t e = hipLaunchCooperativeKernel((const void*)fwd_megakernel, dim3(grid), dim3(NTHREADS), args, LDS_BYTES, stream);
    if (e != hipSuccess) fprintf(stderr, "cooperative launch failed: %s (grid %d)\n", hipGetErrorString(e), grid);
}
```

```cpp
#include <hip/hip_runtime.h>
#include <hip/hip_bf16.h>
#include <hip/hip_cooperative_groups.h>
#include <cstdio>
#include <cstdint>
namespace cg = cooperative_groups;

constexpr int DM = 2048, NB = 8, SEQ = 2048, CTXL = 256, DEPTH = 2;
constexpr int ML = NB * SEQ, MC = NB * CTXL, MT = ML + MC;
constexpr int INW = 2560, QKVW = 1536, FFN = 5632, UPW = 2 * FFN, NMODC = 6 * DM;
constexpr int SKV = SEQ + CTXL;
constexpr float EPS = 1e-6f;
constexpr int NTHREADS = 512, NWAVES = 8;

#define LAS __attribute__((address_space(3)))
#define GAS __attribute__((address_space(1)))
typedef unsigned short bf16_t;
typedef short bf16x8 __attribute__((ext_vector_type(8)));
typedef float f32x4 __attribute__((ext_vector_type(4)));
typedef float f32x2 __attribute__((ext_vector_type(2)));
typedef unsigned u32x4 __attribute__((ext_vector_type(4)));
typedef unsigned u32x2 __attribute__((ext_vector_type(2)));
using f32x16 = __attribute__((ext_vector_type(16))) float;
using s16x4 = __attribute__((ext_vector_type(4))) short;

constexpr size_t MiB = 1u << 20;
constexpr size_t WS_MOD = 1 * MiB;
constexpr size_t WS_MODP = 2 * MiB;
constexpr size_t WS_CWS = 16 * MiB;
constexpr size_t WS_D256 = 17 * MiB;
constexpr size_t WS_D2048 = 18 * MiB;
constexpr size_t WS_WIN = 34 * MiB;
constexpr size_t WS_WOUT = 54 * MiB;
constexpr size_t WS_WUP = 70 * MiB;
constexpr size_t WS_WDN = 158 * MiB;
constexpr size_t WS_XC = 202 * MiB;
constexpr size_t WS_H = 218 * MiB;
constexpr size_t WS_MIX = 290 * MiB;
constexpr size_t WS_R1 = 362 * MiB;
constexpr size_t WS_P = WS_R1;
constexpr size_t WS_QN = WS_R1 + 90 * MiB;
constexpr size_t WS_KALL = WS_R1 + 126 * MiB;
constexpr size_t WS_VALL = WS_R1 + 135 * MiB;
constexpr size_t WS_YTL = WS_R1 + 144 * MiB;
constexpr size_t WS_YTC = WS_R1 + 208 * MiB;
constexpr size_t WS_ATTO = WS_R1 + 216 * MiB;
constexpr size_t WS_FOURO = WS_R1 + 252 * MiB;
constexpr size_t WS_ZP = WS_R1 + 200 * MiB;
constexpr size_t WS_GV = WS_R1 + 207 * MiB;
constexpr size_t WS_VV = WS_R1 + 214 * MiB;
constexpr size_t WS_NYQ = 1 * MiB + 960 * 1024;
constexpr size_t WS_YPART = WS_R1 + 288 * MiB;
constexpr size_t WS_XS = WS_R1 + 320 * MiB;
constexpr size_t WS_END = WS_R1 + 396 * MiB;
constexpr int CWL_OFF = 131072 + 1024;
constexpr int QKP_OFF = CWL_OFF + 4096;
constexpr int LDS_BYTES = 131072 + 1024 + 4096 + 8192;

struct Params { const float* in[21]; float* out; unsigned char* ws; };
typedef const __attribute__((address_space(4))) Params* KP;

__device__ __forceinline__ unsigned cvt_pk_bf16(float lo, float hi) { unsigned r; asm volatile("v_cvt_pk_bf16_f32 %0, %1, %2" : "=v"(r) : "v"(lo), "v"(hi)); return r; }
__device__ __forceinline__ float bf_lo(unsigned w) { return __uint_as_float(w << 16); }
__device__ __forceinline__ float bf_hi(unsigned w) { return __uint_as_float(w & 0xffff0000u); }
template <int K> __device__ __forceinline__ float xor_get(float v) { return __uint_as_float((unsigned)__builtin_amdgcn_ds_swizzle((int)__float_as_uint(v), (K << 10) | 0x1f)); }
__device__ __forceinline__ float half_sum(float v) { auto rr = __builtin_amdgcn_permlane32_swap(__float_as_uint(v), __float_as_uint(v), false, false); return __uint_as_float(rr[0]) + __uint_as_float(rr[1]); }
__device__ __forceinline__ float wave_sum(float v) {
    v += xor_get<1>(v); v += xor_get<2>(v); v += xor_get<4>(v); v += xor_get<8>(v); v += xor_get<16>(v);
    return half_sum(v);
}
__device__ __forceinline__ float gelu_tanh(float z) {
    const float t = z * (0.044715f * z * z + 1.f);
    const float e = __builtin_amdgcn_exp2f(t * (-2.f * 0.7978845608028654f * 1.4426950408889634f));
    return z * __builtin_amdgcn_rcpf(1.f + e);
}

namespace pg8 {
constexpr int BM = 256, BK = 64, HALF = 128, HTB = HALF * BK * 2, STAGE_BYTES = 8 * HTB, NXCD = 8, WGM = 8;
__device__ __forceinline__ int lds_byte(int r, int c) { const int st = (r >> 4) * 2 + (c >> 5), rr = r & 15, cc = c & 31, ob = rr * 64 + cc * 2; return st * 1024 + (ob ^ (((ob >> 9) & 1) << 5)); }
__device__ __forceinline__ void stage_rc(int b, int& R, int& C) { const int st = b / 1024, sb = b % 1024, swz = sb ^ (((sb >> 9) & 1) << 5); R = (st >> 1) * 16 + swz / 64; C = (st & 1) * 32 + (swz % 64) / 2; }
__device__ __forceinline__ int perm32(int rho) { const int n = rho >> 4, i = rho & 15; return 8 * (i >> 2) + 4 * n + (i & 3); }

struct Unit { int pm, pn, ks; };
struct Job {
    const bf16_t* A; const bf16_t* B; bf16_t* O;
    int lda, ldb, ldc, K, nM, nN;
    int ksplit; long ostride_ks;
    int amod, bdiv; long astride, bstride_m, bstride_n;
    int mode; float scale; bf16_t* O2;
    KP pp; unsigned char* ws; int L, which;
    __device__ __forceinline__ const char* aptr(const Unit& u) const { return (const char*)(A + (size_t)(u.pm % amod) * astride + (size_t)u.ks * K); }
    __device__ __forceinline__ const char* bptr(const Unit& u) const { return (const char*)(B + (size_t)(u.pm / bdiv) * bstride_m + (size_t)u.pn * bstride_n + (size_t)u.ks * K); }
};
struct StaticOrder {
    int nM, nN, nwg, G, c, panel;
    __device__ void init(int nM_, int nN_, int G_, int c_) { nM = nM_; nN = nN_; nwg = nM * nN; G = G_; c = c_; panel = 0; }
    __device__ bool next(int i, Unit& u) const {
        if (panel) { const int cp = (G % 8 == 0) ? (c % 8) * (G / 8) + c / 8 : c; const long Lp = (long)i * G + cp; if (Lp >= nwg) return false; u.pm = (int)(Lp / nN); u.pn = (int)(Lp % nN); u.ks = 0; return true; }
        const long L = (long)i * G + c; if (L >= nwg) return false;
        int wgid = (int)L; { const int q = nwg / NXCD, r = nwg % NXCD, xcd = wgid % NXCD, off = wgid / NXCD; wgid = (xcd < r ? xcd * (q + 1) : r * (q + 1) + (xcd - r) * q) + off; }
        const int nig = WGM * nN, gid = wgid / nig, fm = gid * WGM, gsz = (nM - fm) < WGM ? (nM - fm) : WGM;
        u.pm = fm + ((wgid % nig) % gsz); u.pn = (wgid % nig) / gsz; u.ks = 0; return true;
    }
};

__device__ __forceinline__ void panel_rstd(float (&sq)[2][4], float* xbuf, unsigned* pcnt, const Unit& u, int wr, int wc, int fr, int fq, LAS unsigned char* lds) {
    const int lane = fq * 16 + fr, wid = wr * 4 + wc, rl0 = wr * 64 + fr;
    LAS float* part = (LAS float*)(lds + QKP_OFF);
    LAS float* Srs = part + 1024;
#pragma unroll
    for (int ai = 0; ai < 2; ++ai)
#pragma unroll
        for (int m = 0; m < 4; ++m) { float t = sq[ai][m]; t += xor_get<16>(t); t = half_sum(t);
            if (fq == 0) part[(rl0 + 128 * ai + 16 * m) * 4 + wc] = t; }
    asm volatile("s_waitcnt lgkmcnt(0)" ::: "memory"); __builtin_amdgcn_s_barrier(); asm volatile("" ::: "memory");
    const int prow = wid * 32 + (lane & 31);
    if (lane < 32) { const f32x4 p4 = *(const LAS f32x4*)(part + prow * 4);
        __hip_atomic_store(xbuf + ((size_t)u.pm * BM + prow) * 8 + u.pn, (p4[0] + p4[1]) + (p4[2] + p4[3]), __ATOMIC_RELAXED, __HIP_MEMORY_SCOPE_AGENT); }
    asm volatile("s_waitcnt vmcnt(0)" ::: "memory");
    if (lane == 0) __hip_atomic_fetch_add(pcnt + 64 * u.pm, 1u, __ATOMIC_RELAXED, __HIP_MEMORY_SCOPE_AGENT);
    if (wid == 0) { unsigned sp = 0;
        while ((unsigned)__builtin_amdgcn_readfirstlane((int)__hip_atomic_load(pcnt + 64 * u.pm, __ATOMIC_RELAXED, __HIP_MEMORY_SCOPE_AGENT)) < 64u) { __builtin_amdgcn_s_sleep(2); if (++sp > (1u << 16)) break; }
        __builtin_amdgcn_fence(__ATOMIC_ACQUIRE, "agent"); }
    asm volatile("s_waitcnt vmcnt(0) lgkmcnt(0)" ::: "memory"); __builtin_amdgcn_s_barrier(); asm volatile("" ::: "memory");
    if (lane < 32) { const float* xb = xbuf + ((size_t)u.pm * BM + prow) * 8; float t = 0.f;
#pragma unroll
        for (int q = 0; q < 8; ++q) t += __hip_atomic_load(xb + q, __ATOMIC_RELAXED, __HIP_MEMORY_SCOPE_AGENT);
        Srs[prow] = __builtin_amdgcn_rsqf(t * (1.f / DM) + EPS); }
    asm volatile("s_waitcnt lgkmcnt(0)" ::: "memory"); __builtin_amdgcn_s_barrier(); asm volatile("" ::: "memory");
}
__device__ __forceinline__ void epilogue(const Job& J, const f32x4 (&acc)[2][2][4][2], const Unit& u, int wr, int wc, int fr, int fq, LAS unsigned char* lds, int upar) {
    asm volatile("" : "+v"(fr), "+v"(fq));
    const float sc = J.scale;
    if (J.mode == 0 || (J.mode == 3 && u.pn >= 6)) {
        const int row0 = u.pm * BM + wr * 64 + fr, col0 = u.pn * BM + wc * 32 + 8 * fq;
#pragma unroll
        for (int ai = 0; ai < 2; ++ai)
#pragma unroll
            for (int m = 0; m < 4; ++m) { bf16_t* rowp = J.O + (size_t)u.ks * J.ostride_ks + (size_t)(row0 + ai * HALF + m * 16) * J.ldc + col0;
#pragma unroll
                for (int bj = 0; bj < 2; ++bj) { const f32x4 v0 = acc[ai][bj][m][0] * sc, v1 = acc[ai][bj][m][1] * sc;
                    u32x4 w; w.x = cvt_pk_bf16(v0[0], v0[1]); w.y = cvt_pk_bf16(v0[2], v0[3]); w.z = cvt_pk_bf16(v1[0], v1[1]); w.w = cvt_pk_bf16(v1[2], v1[3]);
                    *(u32x4*)(rowp + bj * HALF) = w; } }
    } else if (J.mode == 4 || J.mode == 5) {
        const int rl0 = wr * 64 + fr;
        const LAS float* Srs = (const LAS float*)(lds + QKP_OFF) + 1024;
        float sq[2][4];
#pragma unroll
        for (int ai = 0; ai < 2; ++ai)
#pragma unroll
            for (int m = 0; m < 4; ++m) { float t = 0.f;
#pragma unroll
                for (int bj = 0; bj < 2; ++bj)
#pragma unroll
                    for (int n = 0; n < 2; ++n) { const f32x4 a = acc[ai][bj][m][n]; t += (a[0] * a[0] + a[1] * a[1]) + (a[2] * a[2] + a[3] * a[3]); }
                sq[ai][m] = t; }
        const int Lk = J.L, wh = J.which;
        GAS unsigned char* ws = (GAS unsigned char*)J.ws; KP pp = J.pp; asm volatile("" : "+v"(ws));
        const GAS float* modL = (const GAS float*)(ws + WS_MOD) + (size_t)Lk * 9 * NMODC;
        const int bank = 4 * Lk + 2 * wh;
        float* xbuf1 = (float*)((unsigned char*)ws + WS_MODP) + (size_t)bank * (ML * 8); unsigned* pcnt1 = (unsigned*)(unsigned char*)ws + 4096 + bank * 4096;
        const GAS bf16_t* xs_in = (wh == 0 && Lk == 0) ? (const GAS bf16_t*)nullptr : (const GAS bf16_t*)(ws + WS_XS);
        panel_rstd(sq, xbuf1, pcnt1, u, wr, wc, fr, fq, lds);
        const int col0 = u.pn * BM + wc * 32 + 8 * fq, mr = u.pm >> 3;
        const GAS float* gt = modL + (wh == 0 ? 2 : 5) * DM + (size_t)mr * NMODC + col0; const GAS float* gp0 = (const GAS float*)pp->in[wh == 0 ? 7 : 9]; asm volatile("" : "+v"(gp0)); const GAS float* gp = gp0 + Lk * DM + col0;
#pragma unroll
        for (int ai = 0; ai < 2; ++ai)
#pragma unroll
            for (int m = 0; m < 4; ++m) sq[ai][m] = 0.f;
#pragma unroll
        for (int bj = 0; bj < 2; ++bj) {
            float gg[8];
#pragma unroll
            for (int h = 0; h < 2; ++h) { const f32x4 a = *(const GAS f32x4*)(gt + bj * HALF + 4 * h), b = *(const GAS f32x4*)(gp + bj * HALF + 4 * h);
#pragma unroll
                for (int i = 0; i < 4; ++i) gg[4 * h + i] = a[i] * b[i]; }
#pragma unroll
            for (int ai = 0; ai < 2; ++ai)
#pragma unroll
                for (int m = 0; m < 4; ++m) { const int r = rl0 + 128 * ai + 16 * m; const float rs = Srs[r]; const size_t off = ((size_t)u.pm * BM + r) * DM + col0 + bj * HALF;
                    float x[8];
                    if (xs_in) { const u32x4 xw = *(const GAS u32x4*)(xs_in + off); x[0] = bf_lo(xw.x); x[1] = bf_hi(xw.x); x[2] = bf_lo(xw.y); x[3] = bf_hi(xw.y); x[4] = bf_lo(xw.z); x[5] = bf_hi(xw.z); x[6] = bf_lo(xw.w); x[7] = bf_hi(xw.w); }
                    else { const GAS float* xf = (const GAS float*)pp->in[0]; asm volatile("" : "+v"(xf)); const f32x4 a = *(const GAS f32x4*)(xf + off), b = *(const GAS f32x4*)(xf + off + 4); x[0] = a[0]; x[1] = a[1]; x[2] = a[2]; x[3] = a[3]; x[4] = b[0]; x[5] = b[1]; x[6] = b[2]; x[7] = b[3]; }
#pragma unroll
                    for (int e = 0; e < 8; ++e) x[e] += gg[e] * rs * acc[ai][bj][m][e >> 2][e & 3];
                    if (J.mode == 4) { GAS float* outf = (GAS float*)pp->out; asm volatile("" : "+v"(outf)); *(GAS f32x4*)(outf + off) = (f32x4){x[0], x[1], x[2], x[3]}; *(GAS f32x4*)(outf + off + 4) = (f32x4){x[4], x[5], x[6], x[7]}; }
                    else { u32x4 w; w.x = cvt_pk_bf16(x[0], x[1]); w.y = cvt_pk_bf16(x[2], x[3]); w.z = cvt_pk_bf16(x[4], x[5]); w.w = cvt_pk_bf16(x[6], x[7]);
                        *(GAS u32x4*)((GAS bf16_t*)(ws + WS_XS) + off) = w;
                        const float r0 = bf_lo(w.x), r1 = bf_hi(w.x), r2 = bf_lo(w.y), r3 = bf_hi(w.y), r4 = bf_lo(w.z), r5 = bf_hi(w.z), r6 = bf_lo(w.w), r7 = bf_hi(w.w);
                        sq[ai][m] += (r0 * r0 + r1 * r1) + (r2 * r2 + r3 * r3) + (r4 * r4 + r5 * r5) + (r6 * r6 + r7 * r7); }
                    __builtin_amdgcn_sched_barrier(0); }
        }
        if (J.mode == 5) {
            panel_rstd(sq, xbuf1 + (size_t)(ML * 8), pcnt1 + 4096, u, wr, wc, fr, fq, lds);
            const GAS float* modN = wh == 0 ? modL + 3 * DM : modL + 9 * NMODC;
            const GAS float* sh = modN + (size_t)mr * NMODC + col0; const GAS float* scl = sh + DM; const GAS float* gpr0 = (const GAS float*)(wh == 0 ? pp->in[8] + Lk * DM : pp->in[6] + (Lk + 1) * DM); asm volatile("" : "+v"(gpr0)); const GAS float* gpr = gpr0 + col0;
            GAS bf16_t* Hout = (GAS bf16_t*)(ws + (wh == 0 ? WS_MIX : WS_H));
#pragma unroll
            for (int bj = 0; bj < 2; ++bj) {
                float gs[8], sv[8];
#pragma unroll
                for (int h = 0; h < 2; ++h) { const f32x4 a = *(const GAS f32x4*)(gpr + bj * HALF + 4 * h), b = *(const GAS f32x4*)(scl + bj * HALF + 4 * h), c = *(const GAS f32x4*)(sh + bj * HALF + 4 * h);
#pragma unroll
                    for (int i = 0; i < 4; ++i) { gs[4 * h + i] = a[i] * (b[i] + 1.f); sv[4 * h + i] = c[i]; } }
#pragma unroll
                for (int ai = 0; ai < 2; ++ai)
#pragma unroll
                    for (int m = 0; m < 4; ++m) { const int r = rl0 + 128 * ai + 16 * m; const float rs = Srs[r]; const size_t off = ((size_t)u.pm * BM + r) * DM + col0 + bj * HALF;
                        const u32x4 xw = *(const GAS u32x4*)((const GAS bf16_t*)(ws + WS_XS) + off);
                        float xv[8]; xv[0] = bf_lo(xw.x); xv[1] = bf_hi(xw.x); xv[2] = bf_lo(xw.y); xv[3] = bf_hi(xw.y); xv[4] = bf_lo(xw.z); xv[5] = bf_hi(xw.z); xv[6] = bf_lo(xw.w); xv[7] = bf_hi(xw.w);
                        float h[8];
#pragma unroll
                        for (int e = 0; e < 8; ++e) h[e] = xv[e] * rs * gs[e] + sv[e];
                        u32x4 w; w.x = cvt_pk_bf16(h[0], h[1]); w.y = cvt_pk_bf16(h[2], h[3]); w.z = cvt_pk_bf16(h[4], h[5]); w.w = cvt_pk_bf16(h[6], h[7]);
                        *(GAS u32x4*)(Hout + off) = w;
                        __builtin_amdgcn_sched_barrier(0); }
            }
        }
    } else if (J.mode == 3) {
        const bool lat = u.pm < 64, nrm = u.pn < 5;
        const int rl0 = wr * 64 + fr, cl = wc * 32 + 8 * fq;
        if (nrm) {
            LAS float* part = (LAS float*)(lds + QKP_OFF);
#pragma unroll
            for (int ai = 0; ai < 2; ++ai)
#pragma unroll
                for (int m = 0; m < 4; ++m)
#pragma unroll
                    for (int bj = 0; bj < 2; ++bj) { const f32x4 a = acc[ai][bj][m][0], b = acc[ai][bj][m][1];
                        float sq = (a[0] * a[0] + a[1] * a[1]) + (a[2] * a[2] + a[3] * a[3]) + (b[0] * b[0] + b[1] * b[1]) + (b[2] * b[2] + b[3] * b[3]);
                        sq += xor_get<16>(sq); sq = half_sum(sq);
                        if (fq == 0) part[(rl0 + 128 * ai + 16 * m) * 8 + bj * 4 + wc] = sq; }
            asm volatile("s_waitcnt lgkmcnt(0)" ::: "memory"); __builtin_amdgcn_s_barrier(); asm volatile("" ::: "memory");
        }
        const LAS float* nw = (const LAS float*)(lds + CWL_OFF) + (u.pn == 4 ? 128 : 0) + cl;
        float gw[8];
        { const f32x4 a = *(const LAS f32x4*)nw, b = *(const LAS f32x4*)(nw + 4); gw[0] = a[0]; gw[1] = a[1]; gw[2] = a[2]; gw[3] = a[3]; gw[4] = b[0]; gw[5] = b[1]; gw[6] = b[2]; gw[7] = b[3]; }
        float frq[4];
#pragma unroll
        for (int i = 0; i < 4; ++i) frq[i] = __builtin_amdgcn_exp2f(-(float)((16 * wc + 4 * fq + i) & 31) * (13.287712379549449f / 32.f));
#pragma unroll
        for (int ai = 0; ai < 2; ++ai)
#pragma unroll
            for (int m = 0; m < 4; ++m) {
                const int rl = rl0 + 128 * ai + 16 * m, t = ((u.pm & 7) << 8) + rl;
                float cs[4], sn[4];
#pragma unroll
                for (int i = 0; i < 4; ++i) { cs[i] = 1.f; sn[i] = 0.f; }
                if (lat && nrm) { const float pos = (float)(wc < 2 ? (t >> 6) : (t & 63));
#pragma unroll
                    for (int i = 0; i < 4; ++i) { float rev = pos * frq[i] * 0.15915494309189535f; rev -= floorf(rev); cs[i] = __builtin_amdgcn_cosf(rev); sn[i] = __builtin_amdgcn_sinf(rev); } }
                const size_t row = (size_t)u.pm * BM + rl;
                const size_t kvrow = lat ? (size_t)(u.pm >> 3) * SKV + t : (size_t)(u.pm - 64) * SKV + SEQ + rl;
#pragma unroll
                for (int bj = 0; bj < 2; ++bj) {
                    float v[8];
#pragma unroll
                    for (int e = 0; e < 8; ++e) v[e] = acc[ai][bj][m][e >> 2][e & 3];
                    if (nrm) { const f32x4 p4 = *(const LAS f32x4*)((const LAS float*)(lds + QKP_OFF) + rl * 8 + bj * 4);
                        const float rs = __builtin_amdgcn_rsqf(((p4[0] + p4[1]) + (p4[2] + p4[3])) * (1.f / 128.f) + EPS);
#pragma unroll
                        for (int i = 0; i < 4; ++i) { const float e0 = v[2 * i] * rs * gw[2 * i], o0 = v[2 * i + 1] * rs * gw[2 * i + 1];
                            v[2 * i] = e0 * cs[i] - o0 * sn[i]; v[2 * i + 1] = e0 * sn[i] + o0 * cs[i]; } }
                    u32x4 w; w.x = cvt_pk_bf16(v[0], v[1]); w.y = cvt_pk_bf16(v[2], v[3]); w.z = cvt_pk_bf16(v[4], v[5]); w.w = cvt_pk_bf16(v[6], v[7]);
                    bf16_t* dst = u.pn < 4 ? (bf16_t*)(J.ws + WS_QN) + row * 1024 + (2 * u.pn + bj) * 128 + cl : (bf16_t*)(J.ws + (u.pn == 4 ? WS_KALL : WS_VALL)) + kvrow * 256 + bj * 128 + cl;
                    *(u32x4*)dst = w;
                }
                __builtin_amdgcn_sched_barrier(0);
            }
    } else if (J.mode == 2) {
        const int colg = u.pn * 128 + wc * 32 + 8 * fq, rowb = u.pm * BM + wr * 128 + fr * 8;
        const LAS float* cwl = (const LAS float*)(lds + CWL_OFF + upar * 2048) + wc * 32 + 8 * fq;
        f32x2 w0[4], w1[4], w2[4], bb[4];
#pragma unroll
        for (int h = 0; h < 2; ++h) { const f32x4 a = *(const LAS f32x4*)(cwl + 4 * h), b = *(const LAS f32x4*)(cwl + 128 + 4 * h), c = *(const LAS f32x4*)(cwl + 256 + 4 * h), d = *(const LAS f32x4*)(cwl + 384 + 4 * h);
            w0[2 * h] = (f32x2){a[0], a[1]}; w0[2 * h + 1] = (f32x2){a[2], a[3]}; w1[2 * h] = (f32x2){b[0], b[1]}; w1[2 * h + 1] = (f32x2){b[2], b[3]};
            w2[2 * h] = (f32x2){c[0], c[1]}; w2[2 * h + 1] = (f32x2){c[2], c[3]}; bb[2 * h] = (f32x2){d[0], d[1]}; bb[2 * h + 1] = (f32x2){d[2], d[3]}; }
#define GP2(j, q) ((f32x2){acc[(j) >> 2][0][(j) & 3][(q) >> 1][((q) & 1) * 2], acc[(j) >> 2][0][(j) & 3][(q) >> 1][((q) & 1) * 2 + 1]})
#define VP2(j, q) ((f32x2){acc[(j) >> 2][1][(j) & 3][(q) >> 1][((q) & 1) * 2], acc[(j) >> 2][1][(j) & 3][(q) >> 1][((q) & 1) * 2 + 1]})
        f32x2 gprev[4], gnext[4];
#pragma unroll
        for (int q = 0; q < 4; ++q) {
            const f32x2 last = GP2(7, q), first = GP2(0, q);
            gprev[q].x = __uint_as_float((unsigned)__builtin_amdgcn_update_dpp(0, (int)__float_as_uint(last.x), 0x111, 0xf, 0xf, false));
            gprev[q].y = __uint_as_float((unsigned)__builtin_amdgcn_update_dpp(0, (int)__float_as_uint(last.y), 0x111, 0xf, 0xf, false));
            gnext[q].x = __uint_as_float((unsigned)__builtin_amdgcn_update_dpp(0, (int)__float_as_uint(first.x), 0x101, 0xf, 0xf, false));
            gnext[q].y = __uint_as_float((unsigned)__builtin_amdgcn_update_dpp(0, (int)__float_as_uint(first.y), 0x101, 0xf, 0xf, false));
        }
        bf16_t* orow = J.O + (size_t)rowb * FFN + colg;
#pragma unroll
        for (int j = 0; j < 8; ++j) {
            f32x2 z[4]; unsigned ow[4];
#pragma unroll
            for (int q = 0; q < 4; ++q) {
                const f32x2 gp = j == 0 ? gprev[q] : GP2(j == 0 ? 0 : j - 1, q);
                const f32x2 gn = j == 7 ? gnext[q] : GP2(j == 7 ? 7 : j + 1, q);
                z[q] = gp * w0[q] + (GP2(j, q) * w1[q] + (gn * w2[q] + bb[q]));
                const f32x2 zz = z[q], t = zz * (zz * zz * 0.044715f + 1.0f), ex = t * (-2.302208198f);
                f32x2 d; d.x = __builtin_amdgcn_exp2f(ex.x); d.y = __builtin_amdgcn_exp2f(ex.y); d = d + 1.0f;
                f32x2 r; r.x = __builtin_amdgcn_rcpf(d.x); r.y = __builtin_amdgcn_rcpf(d.y);
                const f32x2 a = zz * r * VP2(j, q);
                ow[q] = cvt_pk_bf16(a.x, a.y);
            }
            u32x4 w; w.x = ow[0]; w.y = ow[1]; w.z = ow[2]; w.w = ow[3];
            *(u32x4*)(orow + (size_t)j * FFN) = w;
            if ((j == 0 && fr == 0) || (j == 7 && fr == 15)) {
                const size_t sb = (size_t)(u.pm * 4 + wr * 2 + (j == 7 ? 1 : 0)) * FFN + colg;
                *(f32x4*)((float*)(J.ws + WS_ZP) + sb) = (f32x4){z[0].x, z[0].y, z[1].x, z[1].y}; *(f32x4*)((float*)(J.ws + WS_ZP) + sb + 4) = (f32x4){z[2].x, z[2].y, z[3].x, z[3].y};
                *(f32x4*)((float*)(J.ws + WS_GV) + sb) = acc[j >> 2][0][j & 3][0]; *(f32x4*)((float*)(J.ws + WS_GV) + sb + 4) = acc[j >> 2][0][j & 3][1];
                *(f32x4*)((float*)(J.ws + WS_VV) + sb) = acc[j >> 2][1][j & 3][0]; *(f32x4*)((float*)(J.ws + WS_VV) + sb + 4) = acc[j >> 2][1][j & 3][1];
            }
        }
#undef GP2
#undef VP2
    } else {
        const bool lat = u.pn < 64;
        const int b = lat ? (u.pn >> 3) : (u.pn - 64), tbase = lat ? (u.pn & 7) * 256 : 0;
        const int ldy = lat ? SEQ : 2 * CTXL; const size_t halfoff = lat ? (size_t)1024 * SEQ : (size_t)CTXL;
        bf16_t* base = (lat ? J.O + (size_t)(b * 2048 + u.pm * 128) * ldy : J.O2 + (size_t)(b * 1024 + u.pm * 128) * ldy) + tbase + wc * 32 + 8 * fq;
#pragma unroll
        for (int ai = 0; ai < 2; ++ai)
#pragma unroll
            for (int m = 0; m < 4; ++m) { bf16_t* rowp = base + (size_t)(wr * 64 + m * 16 + fr) * ldy + ai * halfoff;
#pragma unroll
                for (int bj = 0; bj < 2; ++bj) { const f32x4 v0 = acc[ai][bj][m][0] * sc, v1 = acc[ai][bj][m][1] * sc;
                    u32x4 w; w.x = cvt_pk_bf16(v0[0], v0[1]); w.y = cvt_pk_bf16(v0[2], v0[3]); w.z = cvt_pk_bf16(v1[0], v1[1]); w.w = cvt_pk_bf16(v1[2], v1[3]);
                    *(u32x4*)(rowp + bj * HALF) = w; } }
    }
}

__device__ __forceinline__ void gemm_phase(LAS unsigned char* lds, const Job& g, const StaticOrder& S, const int tid) {
    const int wid = __builtin_amdgcn_readfirstlane(tid >> 6), lane = tid & 63, wr = wid >> 2, wc = wid & 3, fr = lane & 15, fq = lane >> 4;
    const int K = g.K, nt = K / BK;
    unsigned voffA[2], voffB[2];
#pragma unroll
    for (int i = 0; i < 2; ++i) { int R, C; stage_rc(tid * 16 + i * 8192, R, C); const int Rb = (R & ~31) + perm32(R & 31);
        const int Ra = g.mode == 2 ? ((R >> 6) * 128 + (R & 15) * 8 + ((R >> 4) & 3)) : R;
        voffA[i] = (unsigned)(Ra * g.lda + C) * 2u; voffB[i] = (unsigned)(Rb * g.ldb + C) * 2u; }
    const size_t kstep = (size_t)(BK * 2);
    const size_t hstepA = (size_t)(g.mode == 2 ? 4 : HALF) * g.lda * 2, hstepB = (size_t)HALF * g.ldb * 2;
    const unsigned ldsw = (unsigned)wid * 1024u;
    const int aoff = lds_byte(wr * 64 + fr, fq * 8), boff = lds_byte(wc * 32 + fr, fq * 8);
#define PG8_SA(b, h) (((b) * 2 + (h)) * HTB)
#define PG8_SB(b, h) ((4 + (b) * 2 + (h)) * HTB)
#define PG8_STAGE(bufoff, gbase, voff) do { _Pragma("unroll") for (int _i = 0; _i < 2; ++_i) \
        __builtin_amdgcn_global_load_lds((const unsigned*)((const char*)(gbase) + (voff)[_i]), (LAS unsigned*)(lds + (bufoff) + ldsw + _i * 8192), 16, 0, 0); } while (0)
#define PG8_LDA(dst, b, h) do { _Pragma("unroll") for (int m = 0; m < 4; ++m) _Pragma("unroll") for (int k = 0; k < 2; ++k) dst[m][k] = *(const LAS bf16x8*)(lds + PG8_SA(b, h) + aoff + m * 2048 + k * 1024); } while (0)
#define PG8_LDB(dst, b, h) do { _Pragma("unroll") for (int n = 0; n < 2; ++n) _Pragma("unroll") for (int k = 0; k < 2; ++k) dst[n][k] = *(const LAS bf16x8*)(lds + PG8_SB(b, h) + boff + n * 2048 + k * 1024); } while (0)
#define PG8_MMA(ai, bj, At, Bt) do { __builtin_amdgcn_s_setprio(1); _Pragma("unroll") for (int m = 0; m < 4; ++m) _Pragma("unroll") for (int n = 0; n < 2; ++n) _Pragma("unroll") for (int k = 0; k < 2; ++k) \
        acc[ai][bj][m][n] = __builtin_amdgcn_mfma_f32_16x16x32_bf16(Bt[n][k], At[m][k], acc[ai][bj][m][n], 0, 0, 0); __builtin_amdgcn_s_setprio(0); } while (0)
#define PG8_WAIT_V(n) asm volatile("s_waitcnt vmcnt(" #n ")" ::: "memory")
#define PG8_WAIT_L(n) asm volatile("s_waitcnt lgkmcnt(" #n ")" ::: "memory")
#define PG8_BAR __builtin_amdgcn_s_barrier()
#define PG8_SCHED __builtin_amdgcn_sched_barrier(0)
    Unit cur, nxt; int ui = 0;
#define PG8_FIXKS(u) do { if (g.ksplit > 1) { (u).ks = (u).pn / g.nN; (u).pn -= (u).ks * g.nN; } } while (0)
    if (!S.next(0, cur)) return;
    PG8_FIXKS(cur);
    f32x4 acc[2][2][4][2];
#pragma unroll
    for (int a = 0; a < 2; ++a)
#pragma unroll
        for (int b = 0; b < 2; ++b)
#pragma unroll
            for (int m = 0; m < 4; ++m)
#pragma unroll
                for (int n = 0; n < 2; ++n) acc[a][b][m][n] = (f32x4){0.f, 0.f, 0.f, 0.f};
    bf16x8 At[4][2], B0[2][2], B1[2][2];
    const char* cA = g.aptr(cur); const char* cB = g.bptr(cur);
    PG8_STAGE(PG8_SB(0, 0), cB, voffB); PG8_STAGE(PG8_SB(0, 1), cB + hstepB, voffB); PG8_STAGE(PG8_SA(0, 0), cA, voffA); PG8_STAGE(PG8_SA(0, 1), cA + hstepA, voffA);
    if (wr == 1) PG8_BAR;
    PG8_WAIT_V(2); PG8_BAR;
    PG8_STAGE(PG8_SB(1, 0), cB + kstep, voffB); PG8_STAGE(PG8_SA(1, 0), cA + kstep, voffA); PG8_STAGE(PG8_SB(1, 1), cB + hstepB + kstep, voffB);
    PG8_WAIT_V(6); PG8_BAR;
    for (;;) {
        const bool has_next = S.next(ui + 1, nxt);
        if (has_next) PG8_FIXKS(nxt);
        if (g.mode == 2) {
            const int arr = wid >> 1;
            const float* src = (arr < 3 ? g.pp->in[18] + (size_t)g.L * 3 * FFN + arr * FFN : g.pp->in[19] + (size_t)g.L * FFN) + cur.pn * 128 + (wid & 1) * 64 + lane;
            __builtin_amdgcn_global_load_lds((const unsigned*)src, (LAS unsigned*)(lds + CWL_OFF + (ui & 1) * 2048 + wid * 256), 4, 0, 0);
        }
        const char* nA = has_next ? g.aptr(nxt) : cA; const char* nB = has_next ? g.bptr(nxt) : cB;
        for (int t = 0; t < nt; t += 2) {
            const bool last = (t == nt - 2);
            const char* a1 = cA + (size_t)(t + 1) * kstep;
            const char* a2 = last ? nA : cA + (size_t)(t + 2) * kstep; const char* b2 = last ? nB : cB + (size_t)(t + 2) * kstep;
            const char* a3 = a2 + kstep; const char* b3 = b2 + kstep;
            PG8_LDB(B0, 0, 0); PG8_LDB(B1, 0, 1); PG8_SCHED; PG8_LDA(At, 0, 0); PG8_STAGE(PG8_SA(1, 1), a1 + hstepA, voffA);
            PG8_WAIT_V(8); PG8_WAIT_L(0); PG8_BAR; PG8_MMA(0, 0, At, B0); PG8_MMA(0, 1, At, B1); PG8_BAR; PG8_SCHED;
            PG8_LDA(At, 0, 1); PG8_STAGE(PG8_SB(0, 0), b2, voffB); PG8_STAGE(PG8_SB(0, 1), b2 + hstepB, voffB); PG8_STAGE(PG8_SA(0, 0), a2, voffA);
            PG8_WAIT_V(8); PG8_WAIT_L(0); PG8_BAR; PG8_MMA(1, 0, At, B0); PG8_MMA(1, 1, At, B1); PG8_BAR; PG8_SCHED;
            PG8_LDB(B0, 1, 0); PG8_LDB(B1, 1, 1); PG8_SCHED; PG8_LDA(At, 1, 0); PG8_STAGE(PG8_SA(0, 1), a2 + hstepA, voffA);
            PG8_WAIT_V(8); PG8_WAIT_L(0); PG8_BAR; PG8_MMA(0, 0, At, B0); PG8_MMA(0, 1, At, B1); PG8_BAR; PG8_SCHED;
            PG8_LDA(At, 1, 1); PG8_STAGE(PG8_SB(1, 0), b3, voffB); PG8_STAGE(PG8_SB(1, 1), b3 + hstepB, voffB); PG8_STAGE(PG8_SA(1, 0), a3, voffA);
            PG8_WAIT_V(8); PG8_WAIT_L(0); PG8_BAR; PG8_MMA(1, 0, At, B0); PG8_MMA(1, 1, At, B1); PG8_BAR; PG8_SCHED;
        }
        if (wr == 0) PG8_BAR;
        epilogue(g, acc, cur, wr, wc, fr, fq, lds, ui & 1);
        if (!has_next) break;
#pragma unroll
        for (int a = 0; a < 2; ++a)
#pragma unroll
            for (int b = 0; b < 2; ++b)
#pragma unroll
                for (int m = 0; m < 4; ++m)
#pragma unroll
                    for (int n = 0; n < 2; ++n) acc[a][b][m][n] = (f32x4){0.f, 0.f, 0.f, 0.f};
        cur = nxt; cA = nA; cB = nB; ++ui;
        if (wr == 1) PG8_BAR;
    }
    PG8_WAIT_V(0);
    PG8_BAR;
#undef PG8_FIXKS
#undef PG8_SA
#undef PG8_SB
#undef PG8_STAGE
#undef PG8_LDA
#undef PG8_LDB
#undef PG8_MMA
#undef PG8_WAIT_V
#undef PG8_WAIT_L
#undef PG8_BAR
#undef PG8_SCHED
}
}

namespace att {
using bf16 = __hip_bfloat16;
constexpr int D = 128, NW = 8, QBLK = 32, KVBLK = 64;
constexpr float SCALE = 0.088388347648318440f;
constexpr float THR = 8.f;
#ifndef ATT_SDEPTH
#define ATT_SDEPTH 2
#endif
constexpr int LDQ = 1024, LDK = 256, LDO = 1024;
constexpr size_t SHM_V = KVBLK * D * 2, SHM_K = KVBLK * D * 2, SHM_ATTN = 2 * SHM_V + 2 * SHM_K + NW * 64 * 4;
#define KSWZ(row, colB) ((row) * 256 + ((colB) ^ (((row) & 7) << 4)))
#define SBAR() __builtin_amdgcn_sched_barrier(0)
__device__ __forceinline__ int crow(int r, int hi) { return (r & 3) + 8 * (r >> 2) + 4 * hi; }
__device__ __forceinline__ unsigned cvtpk(float lo, float hi) { unsigned r; asm volatile("v_cvt_pk_bf16_f32 %0, %1, %2" : "=v"(r) : "v"(lo), "v"(hi)); return r; }
__device__ __forceinline__ bf16x8 ld8(const bf16* p) { return *reinterpret_cast<const bf16x8*>(p); }
__device__ __forceinline__ void partialSM(f32x16& p0, f32x16& p1, float& m_reg, float& mn, float& alpha) {
  constexpr float C = SCALE * 1.4426950408889634f;
  float pmax = p0[0]; for (int r = 1; r < 16; ++r) pmax = fmaxf(pmax, p0[r]); for (int r = 0; r < 16; ++r) pmax = fmaxf(pmax, p1[r]);
  { auto rr = __builtin_amdgcn_permlane32_swap(__float_as_uint(pmax), __float_as_uint(pmax), false, false);
    pmax = fmaxf(__uint_as_float(rr[0]), __uint_as_float(rr[1])); }
  if (__builtin_expect(__all(pmax - m_reg <= THR / SCALE), 1)) { mn = m_reg; alpha = 1.f; }
  else { mn = fmaxf(m_reg, pmax); alpha = __builtin_amdgcn_exp2f((m_reg - mn) * C); m_reg = mn; }
  float mnC = -mn * C;
  for (int r = 0; r < 16; ++r) p0[r] = fmaf(p0[r], C, mnC); for (int r = 0; r < 16; ++r) p1[r] = fmaf(p1[r], C, mnC);
  for (int r = 0; r < 16; ++r) p0[r] = __builtin_amdgcn_exp2f(p0[r]);
}
__device__ __forceinline__ void finishSM(f32x16& p0, f32x16& p1, float alpha, float& l_reg, bf16x8& pa0, bf16x8& pa1, bf16x8& pa2, bf16x8& pa3) {
  for (int r = 0; r < 16; ++r) p1[r] = __builtin_amdgcn_exp2f(p1[r]);
  float ps = 0; for (int r = 0; r < 16; ++r) ps += p0[r]; for (int r = 0; r < 16; ++r) ps += p1[r];
  { auto rr = __builtin_amdgcn_permlane32_swap(__float_as_uint(ps), __float_as_uint(ps), false, false);
    ps = __uint_as_float(rr[0]) + __uint_as_float(rr[1]); }
  l_reg = l_reg * alpha + ps;
#define PK4(P, BASE, OUT) do { unsigned a0 = cvtpk(P[BASE + 0], P[BASE + 1]), a1 = cvtpk(P[BASE + 2], P[BASE + 3]);   \
    unsigned b0 = cvtpk(P[BASE + 4], P[BASE + 5]), b1 = cvtpk(P[BASE + 6], P[BASE + 7]);                              \
    auto r0 = __builtin_amdgcn_permlane32_swap(a0, b0, false, false); auto r1 = __builtin_amdgcn_permlane32_swap(a1, b1, false, false); \
    u32x4 w = {r0[0], r1[0], r0[1], r1[1]}; OUT = *reinterpret_cast<bf16x8*>(&w); } while (0)
  PK4(p0, 0, pa0); PK4(p0, 8, pa1); PK4(p1, 0, pa2); PK4(p1, 8, pa3);
#undef PK4
}
__device__ __forceinline__ void qkt(f32x16& p0, f32x16& p1, const bf16* Ks, const bf16x8* qr, int r32, int hi) {
  p0 = f32x16{}; p1 = f32x16{};
  for (int d0 = 0; d0 < 8; ++d0) { int cb = (d0 * 16 + hi * 8) * 2;
    bf16x8 b0 = *reinterpret_cast<const bf16x8*>((const char*)Ks + KSWZ(r32, cb));
    bf16x8 b1 = *reinterpret_cast<const bf16x8*>((const char*)Ks + KSWZ(32 + r32, cb));
    p0 = __builtin_amdgcn_mfma_f32_32x32x16_bf16(b0, qr[d0], p0, 0, 0, 0);
    p1 = __builtin_amdgcn_mfma_f32_32x32x16_bf16(b1, qr[d0], p1, 0, 0, 0); }
}
__device__ __forceinline__ int v_st(int k, int c) { const int kk = (k & ~0xC) | ((k & 4) << 1) | ((k & 8) >> 1); return ((kk >> 3) * 4 + (c >> 5)) * 512 + ((kk & 7) * 32 + (c & 31)) * 2; }
__device__ __forceinline__ int v_rd_base(int lane) { return ((lane & 3) << 3) | (((lane >> 2) & 3) << 6) | (((lane >> 4) & 1) << 5) | (((lane >> 5) & 1) << 8); }
constexpr int v_rd_off(int d0, int ks, int half) { return d0 * 512 + ks * 4096 + half * 2048; }
template <int OFF> __device__ __forceinline__ s16x4 tr_read(int vb) {
  s16x4 r; asm volatile("ds_read_b64_tr_b16 %0, %1 offset:%2" : "=&v"(r) : "v"(vb), "i"(OFF) : "memory"); return r;
}
template <int D0> __device__ __forceinline__ void pv_one(f32x16& od, int vb, bf16x8 pa0, bf16x8 pa1, bf16x8 pa2, bf16x8 pa3) {
  const s16x4 l0 = tr_read<v_rd_off(D0, 0, 0)>(vb), h0 = tr_read<v_rd_off(D0, 0, 1)>(vb), l1 = tr_read<v_rd_off(D0, 1, 0)>(vb), h1 = tr_read<v_rd_off(D0, 1, 1)>(vb);
  const s16x4 l2 = tr_read<v_rd_off(D0, 2, 0)>(vb), h2 = tr_read<v_rd_off(D0, 2, 1)>(vb), l3 = tr_read<v_rd_off(D0, 3, 0)>(vb), h3 = tr_read<v_rd_off(D0, 3, 1)>(vb);
  asm volatile("s_waitcnt lgkmcnt(0)" ::: "memory"); SBAR();
#define PK(L, H) (bf16x8){L[0], L[1], L[2], L[3], H[0], H[1], H[2], H[3]}
  od = __builtin_amdgcn_mfma_f32_32x32x16_bf16(pa0, PK(l0, h0), od, 0, 0, 0);
  od = __builtin_amdgcn_mfma_f32_32x32x16_bf16(pa1, PK(l1, h1), od, 0, 0, 0);
  od = __builtin_amdgcn_mfma_f32_32x32x16_bf16(pa2, PK(l2, h2), od, 0, 0, 0);
  od = __builtin_amdgcn_mfma_f32_32x32x16_bf16(pa3, PK(l3, h3), od, 0, 0, 0);
#undef PK
}
__device__ __forceinline__ void pv_d0(f32x16* o, int vb, bf16x8 pa0, bf16x8 pa1, bf16x8 pa2, bf16x8 pa3) {
  pv_one<0>(o[0], vb, pa0, pa1, pa2, pa3); pv_one<1>(o[1], vb, pa0, pa1, pa2, pa3); pv_one<2>(o[2], vb, pa0, pa1, pa2, pa3); pv_one<3>(o[3], vb, pa0, pa1, pa2, pa3);
}
__device__ __forceinline__ void attn_dense_body(const bf16* __restrict__ Qb, const bf16* __restrict__ Kh, const bf16* __restrict__ Vh,
                                                bf16_t* __restrict__ Ob, int seq, char* lds, const int tid) {
  constexpr int SDEPTH = ATT_SDEPTH;
  const int wid = tid >> 6, lane = tid & 63, r32 = lane & 31, hi = lane >> 5;
  bf16* V_lds = (bf16*)lds; bf16* K_lds = (bf16*)(lds + 2 * SHM_V);
  float* ws = (float*)(lds + 2 * SHM_V + 2 * SHM_K) + wid * 64; float* li_l = ws; float* al_l = ws + 32;
  float m_reg = -1e30f, l_reg = 0; f32x16 o[4] = {}; bf16x8 qr[8];
  const bf16* Qw = Qb + (long)(wid * QBLK + r32) * LDQ + hi * 8;
#pragma unroll
  for (int d0 = 0; d0 < 8; ++d0) qr[d0] = ld8(Qw + d0 * 16);
  const int sr = tid >> 4, sc = (tid & 15) * 8, vst0 = v_st(sr, sc), vst1 = v_st(32 + sr, sc);
  const int vb0 = (int)(uintptr_t)V_lds + v_rd_base(lane);
  struct { bf16x8 vs0, vs1, ks0, ks1; } sr_[SDEPTH];
  const unsigned loff = (unsigned)(sr * LDK + sc) * 2u;
#define SLOAD(i, k0) do { const char* vb_ = (const char*)(Vh + (long)(k0) * LDK); const char* kb_ = (const char*)(Kh + (long)(k0) * LDK); \
    sr_[i].vs0 = *(const bf16x8*)(vb_ + loff); sr_[i].vs1 = *(const bf16x8*)(vb_ + 32 * LDK * 2 + loff); \
    sr_[i].ks0 = *(const bf16x8*)(kb_ + loff); sr_[i].ks1 = *(const bf16x8*)(kb_ + 32 * LDK * 2 + loff); } while (0)
#define SWRITE(b, i) do { *(bf16x8*)((char*)V_lds + (b) * SHM_V + vst0) = sr_[i].vs0;          \
    *(bf16x8*)((char*)V_lds + (b) * SHM_V + vst1) = sr_[i].vs1; int kc = sc * 2;               \
    *(bf16x8*)((char*)K_lds + (b) * SHM_K + KSWZ(sr, kc)) = sr_[i].ks0;                       \
    *(bf16x8*)((char*)K_lds + (b) * SHM_K + KSWZ(32 + sr, kc)) = sr_[i].ks1; } while (0)
#define SWAIT() do { if constexpr (SDEPTH == 2) asm volatile("s_waitcnt vmcnt(4)" ::: "memory"); else asm volatile("s_waitcnt vmcnt(0)" ::: "memory"); } while (0)
#define RESC(a) do { if (__any((a) < 1.f)) { if (hi == 0) al_l[r32] = (a); asm volatile("s_waitcnt lgkmcnt(0)" ::: "memory"); \
    for (int d = 0; d < 4; ++d) for (int r = 0; r < 16; ++r) o[d][r] *= al_l[crow(r, hi)]; } } while (0)
  f32x16 pA0, pA1, pB0, pB1; float mnA, mnB, alA, alB; bf16x8 pa0, pa1, pa2, pa3; const int NT = seq / KVBLK;
  constexpr int SE = 0, SO = SDEPTH - 1;
  SLOAD(SE, 0); asm volatile("s_waitcnt vmcnt(0)" ::: "memory"); SWRITE(0, SE); __syncthreads();
  qkt(pA0, pA1, K_lds, qr, r32, hi); partialSM(pA0, pA1, m_reg, mnA, alA);
  SLOAD(SO, KVBLK); if constexpr (SDEPTH == 2) { if (2 < NT) SLOAD(SE, 2 * KVBLK); }
  SWAIT(); SWRITE(1, SO); __syncthreads();
  for (int j = 1; j + 1 < NT; j += 2) {
    SBAR(); qkt(pB0, pB1, (bf16*)((char*)K_lds + SHM_K), qr, r32, hi);
    finishSM(pA0, pA1, alA, l_reg, pa0, pa1, pa2, pa3); SBAR();
    SLOAD(SO, (j + SDEPTH) * KVBLK); SBAR();
    pv_d0(o, vb0, pa0, pa1, pa2, pa3); partialSM(pB0, pB1, m_reg, mnB, alB);
    __syncthreads(); SWAIT(); SWRITE(0, SE);
    RESC(alB); __syncthreads();
    SBAR(); qkt(pA0, pA1, K_lds, qr, r32, hi);
    finishSM(pB0, pB1, alB, l_reg, pa0, pa1, pa2, pa3); SBAR();
    if (SDEPTH == 1 || j + 3 < NT) SLOAD(SE, (j + 1 + SDEPTH) * KVBLK); SBAR();
    pv_d0(o, vb0 + (int)SHM_V, pa0, pa1, pa2, pa3); partialSM(pA0, pA1, m_reg, mnA, alA);
    __syncthreads(); SWAIT(); SWRITE(1, SO);
    RESC(alA); __syncthreads();
  }
  SBAR(); qkt(pB0, pB1, (bf16*)((char*)K_lds + SHM_K), qr, r32, hi);
  finishSM(pA0, pA1, alA, l_reg, pa0, pa1, pa2, pa3); SBAR();
  pv_d0(o, vb0, pa0, pa1, pa2, pa3); partialSM(pB0, pB1, m_reg, mnB, alB);
  __syncthreads(); RESC(alB);
  finishSM(pB0, pB1, alB, l_reg, pa0, pa1, pa2, pa3); SBAR();
  pv_d0(o, vb0 + (int)SHM_V, pa0, pa1, pa2, pa3);
  if (hi == 0) li_l[r32] = l_reg; asm volatile("s_waitcnt lgkmcnt(0)" ::: "memory");
  float rli[16];
#pragma unroll
  for (int r = 0; r < 16; ++r) rli[r] = __builtin_amdgcn_rcpf(li_l[crow(r, hi)]);
  bf16_t* Ow = Ob + (long)(wid * QBLK) * LDO;
#pragma unroll
  for (int r = 0; r < 16; ++r) { int orow = crow(r, hi);
    for (int d0 = 0; d0 < 4; ++d0) Ow[(long)orow * LDO + d0 * 32 + r32] = (bf16_t)(cvtpk(o[d0][r] * rli[r], 0.f) & 0xffffu); }
#undef SLOAD
#undef SWRITE
#undef SWAIT
#undef RESC
}
#undef KSWZ
#undef SBAR
}

template <bool GLU> __device__ __forceinline__ void p0_transpose_item(const float* W, int K, int N, bf16_t* WT, LAS float* scr, int item, int lane) {
    const int nblk = N / 32, kb = item / nblk, nb = item % nblk, k0 = 64 * kb, n0 = 32 * nb;
    const int n0d = !GLU ? n0 : (n0 < FFN ? (n0 >> 7) * 256 + (n0 & 127) : ((n0 - FFN) >> 7) * 256 + 128 + ((n0 - FFN) & 127));
    float v[32];
    const float* wp0 = W + (size_t)(k0 + (lane >> 5)) * N + n0 + (lane & 31);
#pragma unroll
    for (int i = 0; i < 32; ++i) v[i] = wp0[(size_t)(2 * i) * N];
#pragma unroll
    for (int i = 0; i < 32; ++i) scr[(2 * i + (lane >> 5)) * 33 + (lane & 31)] = v[i];
    asm volatile("s_waitcnt lgkmcnt(0)" ::: "memory");
    const int c = lane & 7;
#pragma unroll
    for (int j = 0; j < 4; ++j) { const int n = (lane >> 3) + 8 * j; const LAS float* s = scr + (8 * c) * 33 + n;
        u32x4 o; o.x = cvt_pk_bf16(s[0 * 33], s[1 * 33]); o.y = cvt_pk_bf16(s[2 * 33], s[3 * 33]); o.z = cvt_pk_bf16(s[4 * 33], s[5 * 33]); o.w = cvt_pk_bf16(s[6 * 33], s[7 * 33]);
        *(u32x4*)(WT + (size_t)(n0d + n) * K + k0 + 8 * c) = o; }
    asm volatile("s_waitcnt lgkmcnt(0)" ::: "memory");
}

__device__ __forceinline__ void phase0(KP pp, LAS unsigned char* lds, int G, const int tid, const int bid) {
    const int lane = tid & 63, wave = tid >> 6;
    unsigned char* ws = pp->ws;
    LAS float* sv = (LAS float*)lds;
    for (int i = tid; i < 9 * DM; i += NTHREADS) { const int r = i / DM, k = i % DM; const float v = r < 8 ? pp->in[1][r * DM + k] : pp->in[3][k];
        sv[i] = v / (1.f + __expf(-v)); }
    __syncthreads();
    {
        const float* wmod = pp->in[4]; float* part = (float*)(ws + WS_MODP);
        LAS float* red = (LAS float*)(lds + 9 * DM * 4);
        const int grp = tid >> 7, t7 = tid & 127;
        for (int it = bid; it < 768; it += G) {
            const int L = it / 384, rem = it % 384, cb = rem % 24, kc = rem / 24;
            const int col = cb * 512 + t7 * 4, kb = kc * 128 + grp * 32;
            f32x4 acc[9];
#pragma unroll
            for (int r = 0; r < 9; ++r) acc[r] = (f32x4){0.f, 0.f, 0.f, 0.f};
            const float* wp = wmod + ((size_t)L * DM + kb) * NMODC + col;
#pragma unroll 8
            for (int k = 0; k < 32; ++k) { const f32x4 w = *(const f32x4*)(wp + (size_t)k * NMODC);
#pragma unroll
                for (int r = 0; r < 9; ++r) acc[r] += w * sv[r * DM + kb + k]; }
            if (grp > 0) {
#pragma unroll
                for (int r = 0; r < 9; ++r) *(LAS f32x4*)(red + ((grp - 1) * 9 + r) * 512 + t7 * 4) = acc[r];
            }
            __syncthreads();
            if (grp == 0) {
#pragma unroll
                for (int r = 0; r < 9; ++r) { f32x4 a = acc[r];
#pragma unroll
                    for (int g2 = 0; g2 < 3; ++g2) a += *(const LAS f32x4*)(red + (g2 * 9 + r) * 512 + t7 * 4);
                    *(f32x4*)(part + ((size_t)(kc * 2 + L) * 9 + r) * NMODC + col) = a; }
            }
            __syncthreads();
        }
    }
    __syncthreads();
    {
        LAS float* scr = (LAS float*)(lds + wave * 16384);
        const int gw = bid * NWAVES + wave, NGW = G * NWAVES;
        constexpr int I_IN = (DM / 64) * (INW / 32), I_OUT = (DM / 64) * (DM / 32), I_UP = (DM / 64) * (UPW / 32), I_DN = (FFN / 64) * (DM / 32);
        constexpr int PER = I_IN + I_OUT + I_UP + I_DN;
        for (int it = gw; it < 2 * PER; it += NGW) {
            const int L = it / PER; int r = it % PER;
            if (r < I_IN) { p0_transpose_item<false>(pp->in[10] + (size_t)L * DM * INW, DM, INW, (bf16_t*)(ws + WS_WIN) + (size_t)L * INW * DM, scr, r, lane); continue; } r -= I_IN;
            if (r < I_OUT) { p0_transpose_item<false>(pp->in[16] + (size_t)L * DM * DM, DM, DM, (bf16_t*)(ws + WS_WOUT) + (size_t)L * DM * DM, scr, r, lane); continue; } r -= I_OUT;
            if (r < I_UP) { p0_transpose_item<true>(pp->in[17] + (size_t)L * DM * UPW, DM, UPW, (bf16_t*)(ws + WS_WUP) + (size_t)L * UPW * DM, scr, r, lane); continue; } r -= I_UP;
            p0_transpose_item<false>(pp->in[20] + (size_t)L * FFN * DM, FFN, DM, (bf16_t*)(ws + WS_WDN) + (size_t)L * DM * FFN, scr, r, lane);
        }
    }
    __syncthreads();
    {
        const int gt = bid * NTHREADS + tid, NGT = G * NTHREADS;
        bf16_t* d2048 = (bf16_t*)(ws + WS_D2048);
        for (int it = gt; it < 2048 * 2048 / 8; it += NGT) {
            const int r = it / 256, t0 = (it % 256) * 8, k = r & 1023; float v[8];
#pragma unroll
            for (int e = 0; e < 8; ++e) { const float rev = (float)((k * (t0 + e)) & 2047) * (1.f / 2048.f);
                v[e] = r < 1024 ? __builtin_amdgcn_cosf(rev) : __builtin_amdgcn_sinf(rev); }
            u32x4 o; o.x = cvt_pk_bf16(v[0], v[1]); o.y = cvt_pk_bf16(v[2], v[3]); o.z = cvt_pk_bf16(v[4], v[5]); o.w = cvt_pk_bf16(v[6], v[7]);
            *(u32x4*)(d2048 + (size_t)r * 2048 + t0) = o;
        }
        bf16_t* d256 = (bf16_t*)(ws + WS_D256);
        for (int it = gt; it < 256 * 512 / 8; it += NGT) {
            const int k = it / 64, tt0 = (it % 64) * 8; float v[8];
#pragma unroll
            for (int e = 0; e < 8; ++e) { const int tt = tt0 + e, t = tt & 255; const float rev = (float)((k * t) & 255) * (1.f / 256.f);
                v[e] = tt < 256 ? __builtin_amdgcn_cosf(rev) : -__builtin_amdgcn_sinf(rev); }
            u32x4 o; o.x = cvt_pk_bf16(v[0], v[1]); o.y = cvt_pk_bf16(v[2], v[3]); o.z = cvt_pk_bf16(v[4], v[5]); o.w = cvt_pk_bf16(v[6], v[7]);
            *(u32x4*)(d256 + (size_t)k * 512 + tt0) = o;
        }
        LAS float* tab = (LAS float*)lds;
        LAS float* wl = (LAS float*)lds + 256;
        const float* wf = pp->in[13]; bf16_t* cws = (bf16_t*)(ws + WS_CWS);
        for (int it = bid; it < 256; it += G) {
            const int lg = it >> 4, half = (it >> 3) & 1, cblk = it & 7;
            __syncthreads();
            if (tid < 128) { const float rev = (float)tid * (1.f / 128.f); tab[tid] = __builtin_amdgcn_cosf(rev); tab[128 + tid] = __builtin_amdgcn_sinf(rev); }
#pragma unroll
            for (int i = 0; i < 8; ++i) *(LAS f32x4*)(wl + (i * 512 + tid) * 4) = *(const f32x4*)(wf + (size_t)lg * 16384 + (i * 512 + tid) * 4);
            __syncthreads();
            const int d = tid & 127, c0 = cblk * 16 + (tid >> 7) * 4;
            const LAS float* tb = tab + half * 128;
            float s0 = 0.f, s1 = 0.f, s2 = 0.f, s3 = 0.f;
#pragma unroll 8
            for (int l = 0; l < 128; ++l) { const float w = wl[l * 128 + d];
                s0 += tb[(l * c0) & 127] * w; s1 += tb[(l * (c0 + 1)) & 127] * w; s2 += tb[(l * (c0 + 2)) & 127] * w; s3 += tb[(l * (c0 + 3)) & 127] * w; }
            u32x2 o; o.x = cvt_pk_bf16(s0, s1); o.y = cvt_pk_bf16(s2, s3);
            *(u32x2*)(cws + ((size_t)lg * 256 + half * 128 + d) * 128 + c0) = o;
        }
    }
}

__device__ __forceinline__ void phase0b(KP pp, int G, const int tid, const int bid) {
    const int gt = bid * NTHREADS + tid, NGT = G * NTHREADS;
    const float* part = (const float*)(pp->ws + WS_MODP); float* mod = (float*)(pp->ws + WS_MOD); const float* bmod = pp->in[5];
    for (int i = gt; i < 2 * 9 * NMODC; i += NGT) {
        const int col = i % NMODC, L = i / (9 * NMODC);
        float s = bmod[L * NMODC + col];
#pragma unroll
        for (int kc = 0; kc < 16; ++kc) s += part[(size_t)kc * 2 * 9 * NMODC + i];
        mod[i] = s;
    }
}

struct RM {
    int row0, nrows;
    const float* srcL; const float* srcC; const bf16_t* srcB; float* dstF; bf16_t* dstB;
    const bf16_t* y; const bf16_t* ysplit; const float* gate; const float* gpost;
    bf16_t* H; const float* gpre; const float* shift; const float* scale;
};
__device__ __forceinline__ void resid_mod(const RM& a, int G, const int tid, const int bid) {
    const int lane = tid & 63, gw = bid * NWAVES + (tid >> 6), NGW = G * NWAVES;
    for (int row = a.row0 + gw; row < a.nrows; row += NGW) {
        const bool lat = row < ML; const int mr = lat ? row / SEQ : 8;
        f32x4 x[8];
        if (a.srcB) {
            u32x2 w[8];
#pragma unroll
            for (int j = 0; j < 8; ++j) w[j] = *(const u32x2*)(a.srcB + (size_t)row * DM + j * 256 + lane * 4);
#pragma unroll
            for (int j = 0; j < 8; ++j) x[j] = (f32x4){bf_lo(w[j].x), bf_hi(w[j].x), bf_lo(w[j].y), bf_hi(w[j].y)};
        } else {
            const float* src = lat ? a.srcL + (size_t)row * DM : a.srcC + (size_t)(row - ML) * DM;
#pragma unroll
            for (int j = 0; j < 8; ++j) x[j] = *(const f32x4*)(src + j * 256 + lane * 4);
        }
        if (a.y) {
            const bf16_t* yr = a.y + (size_t)row * DM; f32x4 yv[8]; float ss = 0.f;
            if (lat || !a.ysplit) {
                u32x2 w[8];
#pragma unroll
                for (int j = 0; j < 8; ++j) w[j] = *(const u32x2*)(yr + j * 256 + lane * 4);
#pragma unroll
                for (int j = 0; j < 8; ++j) yv[j] = (f32x4){bf_lo(w[j].x), bf_hi(w[j].x), bf_lo(w[j].y), bf_hi(w[j].y)};
            } else {
#pragma unroll
                for (int j = 0; j < 8; ++j) yv[j] = (f32x4){0.f, 0.f, 0.f, 0.f};
#pragma unroll
                for (int ks = 0; ks < 4; ++ks) {
                    u32x2 w[8];
#pragma unroll
                    for (int j = 0; j < 8; ++j) w[j] = *(const u32x2*)(a.ysplit + ((size_t)ks * MC + (row - ML)) * DM + j * 256 + lane * 4);
#pragma unroll
                    for (int j = 0; j < 8; ++j) yv[j] += (f32x4){bf_lo(w[j].x), bf_hi(w[j].x), bf_lo(w[j].y), bf_hi(w[j].y)};
                }
            }
#pragma unroll
            for (int j = 0; j < 8; ++j) ss += (yv[j].x * yv[j].x + yv[j].y * yv[j].y) + (yv[j].z * yv[j].z + yv[j].w * yv[j].w);
            const float rstd = __builtin_amdgcn_rsqf(wave_sum(ss) * (1.f / DM) + EPS);
            const float* gt = a.gate + (size_t)mr * NMODC;
#pragma unroll
            for (int j = 0; j < 8; ++j) { const int e = j * 256 + lane * 4; const f32x4 g = *(const f32x4*)(gt + e), gp = *(const f32x4*)(a.gpost + e);
                x[j] = x[j] + g * (yv[j] * rstd * gp);
                if (a.dstB) { u32x2 w; w.x = cvt_pk_bf16(x[j].x, x[j].y); w.y = cvt_pk_bf16(x[j].z, x[j].w); *(u32x2*)(a.dstB + (size_t)row * DM + e) = w;
                    x[j] = (f32x4){bf_lo(w.x), bf_hi(w.x), bf_lo(w.y), bf_hi(w.y)}; }
                else *(f32x4*)(a.dstF + (size_t)row * DM + e) = x[j]; }
        }
        if (a.H) {
            float ss = 0.f;
#pragma unroll
            for (int j = 0; j < 8; ++j) ss += (x[j].x * x[j].x + x[j].y * x[j].y) + (x[j].z * x[j].z + x[j].w * x[j].w);
            const float rstd = __builtin_amdgcn_rsqf(wave_sum(ss) * (1.f / DM) + EPS);
            const float* sh = a.shift + (size_t)mr * NMODC; const float* scl = a.scale + (size_t)mr * NMODC; bf16_t* hr = a.H + (size_t)row * DM;
#pragma unroll
            for (int j = 0; j < 8; ++j) { const int e = j * 256 + lane * 4; const f32x4 g = *(const f32x4*)(a.gpre + e), s1 = *(const f32x4*)(scl + e), s0 = *(const f32x4*)(sh + e);
                const f32x4 h = (x[j] * rstd * g) * (s1 + 1.f) + s0; u32x2 w; w.x = cvt_pk_bf16(h.x, h.y); w.y = cvt_pk_bf16(h.z, h.w);
                *(u32x2*)(hr + e) = w; }
        }
    }
}

__device__ __forceinline__ void merge_phase(const bf16_t* attO, const bf16_t* fourO, const float* nyq, const float* gattn, const float* gfour, bf16_t* Y, int nrows, int G, const int tid, const int bid) {
    const int lane = tid & 63, gw = bid * NWAVES + (tid >> 6), NGW = G * NWAVES;
    for (int row = gw; row < nrows; row += NGW) {
        f32x4 a[4], f[4]; float sa = 0.f, sf = 0.f;
#pragma unroll
        for (int j = 0; j < 4; ++j) { const u32x2 w = *(const u32x2*)(attO + (size_t)row * 1024 + j * 256 + lane * 4); a[j] = (f32x4){bf_lo(w.x), bf_hi(w.x), bf_lo(w.y), bf_hi(w.y)}; }
        if (row < ML) {
            const int b = row >> 11, k = row & 2047, kk = k <= 1024 ? k : 2048 - k; const float sg = k <= 1024 ? -1.f : 1.f;
            const bool hasS = (kk != 0 && kk != 1024);
            const bf16_t* crow = fourO + ((size_t)b * 2048 + (kk < 1024 ? kk : 0)) * 1024; const bf16_t* srow = fourO + ((size_t)b * 2048 + 1024 + (hasS ? kk : 0)) * 1024;
            u32x2 wc[4], wsn[4];
#pragma unroll
            for (int j = 0; j < 4; ++j) { wc[j] = *(const u32x2*)(crow + j * 256 + lane * 4); wsn[j] = *(const u32x2*)(srow + j * 256 + lane * 4); }
#pragma unroll
            for (int j = 0; j < 4; ++j) { f32x4 c = (f32x4){bf_lo(wc[j].x), bf_hi(wc[j].x), bf_lo(wc[j].y), bf_hi(wc[j].y)};
                if (kk == 1024) c = *(const f32x4*)(nyq + b * 1024 + j * 256 + lane * 4);
                const f32x4 sv = (f32x4){bf_lo(wsn[j].x), bf_hi(wsn[j].x), bf_lo(wsn[j].y), bf_hi(wsn[j].y)};
                f[j] = hasS ? c + sv * sg : c; }
        } else {
#pragma unroll
            for (int j = 0; j < 4; ++j) { const u32x2 w = *(const u32x2*)(fourO + (size_t)row * 1024 + j * 256 + lane * 4); f[j] = (f32x4){bf_lo(w.x), bf_hi(w.x), bf_lo(w.y), bf_hi(w.y)}; }
        }
#pragma unroll
        for (int j = 0; j < 4; ++j) {
            sa += (a[j].x * a[j].x + a[j].y * a[j].y) + (a[j].z * a[j].z + a[j].w * a[j].w);
            sf += (f[j].x * f[j].x + f[j].y * f[j].y) + (f[j].z * f[j].z + f[j].w * f[j].w); }
        const float ra = __builtin_amdgcn_rsqf(wave_sum(sa) * (1.f / 1024.f) + EPS), rf = __builtin_amdgcn_rsqf(wave_sum(sf) * (1.f / 1024.f) + EPS);
        bf16_t* yr = Y + (size_t)row * DM;
#pragma unroll
        for (int j = 0; j < 4; ++j) { const int e = j * 256 + lane * 4; const f32x4 ga = *(const f32x4*)(gattn + e), gf = *(const f32x4*)(gfour + e);
            const f32x4 va = a[j] * ra * ga, vf = f[j] * rf * gf; u32x2 w; w.x = cvt_pk_bf16(va.x, va.y); w.y = cvt_pk_bf16(va.z, va.w); *(u32x2*)(yr + e) = w;
            w.x = cvt_pk_bf16(vf.x, vf.y); w.y = cvt_pk_bf16(vf.z, vf.w); *(u32x2*)(yr + 1024 + e) = w; }
    }
}

__device__ __forceinline__ void nyq_phase(const bf16_t* YTL, float* nyq, int G, const int tid, const int bid) {
    const int lane = tid & 63, gw = bid * NWAVES + (tid >> 6), NGW = G * NWAVES;
    for (int idx = gw; idx < NB * 1024; idx += NGW) {
        const int b = idx >> 10, ch = idx & 1023;
        const bf16_t* r = YTL + ((size_t)(b * 2) * 1024 + ch) * SEQ + lane * 8;
        float s = 0.f;
#pragma unroll
        for (int i = 0; i < 4; ++i) { const u32x4 w = *(const u32x4*)(r + i * 512);
            s += (bf_lo(w.x) - bf_hi(w.x)) + (bf_lo(w.y) - bf_hi(w.y)) + (bf_lo(w.z) - bf_hi(w.z)) + (bf_lo(w.w) - bf_hi(w.w)); }
        s = wave_sum(s);
        if (lane == 0) nyq[idx] = s * (1.f / 512.f);
    }
}

__device__ __forceinline__ void glufix_phase(bf16_t* Aact, const float* zp, const float* gv, const float* vv, const float* cw, int nrows, int G, const int tid, const int bid) {
    const int gt = bid * NTHREADS + tid, NGT = G * NTHREADS;
    constexpr int NC4 = FFN / 4;
    const int nitems = (nrows / 256) * 4 * NC4;
    for (int it = gt; it < nitems; it += NGT) {
        const int brow = it / NC4, col = (it % NC4) * 4, k = brow & 3, pm = brow >> 2;
        const int r = pm * 256 + (k == 0 ? 0 : k == 1 ? 127 : k == 2 ? 128 : 255);
        const int slen = r < ML ? SEQ : CTXL;
        f32x4 miss = (f32x4){0.f, 0.f, 0.f, 0.f}; const float* wsel = cw + ((k & 1) ? 2 * FFN : 0) + col;
        if (k == 0) { if ((r % slen) != 0) miss = *(const f32x4*)(gv + (size_t)(brow - 1) * FFN + col); }
        else if (k == 3) { if (((r + 1) % slen) != 0) miss = *(const f32x4*)(gv + (size_t)(brow + 1) * FFN + col); }
        else miss = *(const f32x4*)(gv + (size_t)(k == 1 ? brow + 1 : brow - 1) * FFN + col);
        const f32x4 z = *(const f32x4*)(zp + (size_t)brow * FFN + col) + miss * *(const f32x4*)wsel, v = *(const f32x4*)(vv + (size_t)brow * FFN + col);
        u32x2 w; w.x = cvt_pk_bf16(gelu_tanh(z.x) * v.x, gelu_tanh(z.y) * v.y); w.y = cvt_pk_bf16(gelu_tanh(z.z) * v.z, gelu_tanh(z.w) * v.w);
        *(u32x2*)(Aact + (size_t)r * FFN + col) = w;
    }
}

#define XB_TMO      128
#define XB_XCNT(j)  (256  + 64 * (j))
#define XB_XSUB(j)  (1280 + 64 * (j))
#define XB_XGEN(j)  (2304 + 64 * (j))
#define XB_TOP      3328
#define XB_TOPGEN   3392
#define XCD_BAR_WORDS 3456
#define XB_SPIN_CAP (1u << 18)
__device__ __forceinline__ unsigned xb_ld(unsigned* p)              { return __hip_atomic_load(p, __ATOMIC_RELAXED, __HIP_MEMORY_SCOPE_AGENT); }
__device__ __forceinline__ unsigned xb_add(unsigned* p, unsigned v) { return __hip_atomic_fetch_add(p, v, __ATOMIC_RELAXED, __HIP_MEMORY_SCOPE_AGENT); }
__device__ __forceinline__ unsigned xb_xcc_id() { return (unsigned)__builtin_amdgcn_s_getreg((3 << 11) | 20) & 0xFu; }
#define XB_SPIN(cond, bar) do { unsigned _sp = 0; while (cond) { __builtin_amdgcn_s_sleep(1); \
    if ((++_sp & 255u) == 0u) { if (xb_ld(&(bar)[XB_TMO])) break; if (_sp > XB_SPIN_CAP) { atomicAdd(&(bar)[XB_TMO], 1u); break; } } } } while (0)
struct XcdBarrier { unsigned* bar; unsigned x; volatile LAS unsigned* st; };
__device__ __forceinline__ void xcd_barrier_complete(unsigned* bar, unsigned x, unsigned& nloc, unsigned& nx) {
    const unsigned G = gridDim.x * gridDim.y * gridDim.z;
    unsigned sum, cnt, mine, sp = 0u;
    for (;;) {
        sum = 0u; cnt = 0u; mine = 0u;
#pragma unroll
        for (unsigned j = 0; j < 16; ++j) { const unsigned c = xb_ld(&bar[XB_XCNT(j)]); sum += c; cnt += (c > 0u) ? 1u : 0u; mine = (j == x) ? c : mine; }
        if (sum == G) break;
        __builtin_amdgcn_s_sleep(1);
        if ((++sp & 255u) == 0u) { if (xb_ld(&bar[XB_TMO])) break; if (sp > XB_SPIN_CAP) { atomicAdd(&bar[XB_TMO], 1u); break; } }
    }
    nloc = mine > 0u ? mine : 1u; nx = cnt > 0u ? cnt : 1u;
}
__device__ __forceinline__ void xcd_barrier(const XcdBarrier& b, const int tid) {
    asm volatile("s_waitcnt vmcnt(0)" ::: "memory");
    __syncthreads();
    if (tid == 0) {
        unsigned* bar = b.bar;
        __builtin_amdgcn_s_waitcnt(0);
        unsigned nloc = b.st[0], nx = b.st[1];
        if (nloc == 0u) { xcd_barrier_complete(bar, b.x, nloc, nx); b.st[0] = nloc; b.st[1] = nx; }
        const unsigned old = xb_add(&bar[XB_XSUB(b.x)], 1u);
        const unsigned gen = old / nloc;
        if (old + 1u == (gen + 1u) * nloc) {
            __builtin_amdgcn_fence(__ATOMIC_RELEASE, "agent");
            asm volatile("s_waitcnt vmcnt(0)" ::: "memory");
            const unsigned og = xb_add(&bar[XB_TOP], 1u);
            const unsigned tg = og / nx;
            if (og + 1u == (tg + 1u) * nx) xb_add(&bar[XB_TOPGEN], 1u);
            else XB_SPIN(xb_ld(&bar[XB_TOPGEN]) == tg, bar);
            __builtin_amdgcn_fence(__ATOMIC_ACQUIRE, "agent");
            xb_add(&bar[XB_XGEN(b.x)], 1u);
            asm volatile("s_waitcnt vmcnt(0)" ::: "memory");
        } else {
            XB_SPIN(xb_ld(&bar[XB_XGEN(b.x)]) == gen, bar);
            __builtin_amdgcn_fence(__ATOMIC_ACQUIRE, "agent");
            asm volatile("s_waitcnt vmcnt(0)" ::: "memory");
        }
    }
    __syncthreads();
}

enum { ST_P0 = 0, ST_P0B, ST_RM0, ST_G1, ST_QK, ST_ATT, ST_MRG, ST_G2, ST_RM1, ST_G3, ST_CGLU, ST_G4, ST_RM2 };

__global__ void __launch_bounds__(NTHREADS, 2) fwd_megakernel(Params p_arg) {
    (void)p_arg;
    extern __shared__ __attribute__((aligned(16))) unsigned char lds_raw[];
    cg::grid_group grid = cg::this_grid();
    const int G_u = gridDim.x;
    const int wv_u = __builtin_amdgcn_readfirstlane((int)(threadIdx.x >> 6));
    {
        volatile LAS unsigned* st0 = (volatile LAS unsigned*)((LAS unsigned char*)lds_raw + 131072);
        if (threadIdx.x < 2) st0[threadIdx.x] = 0u;
        __syncthreads();
        if (threadIdx.x == 0) { KP pp0 = (KP)__builtin_amdgcn_kernarg_segment_ptr(); (void)xb_add((unsigned*)pp0->ws + XB_XCNT(xb_xcc_id()), 1u); }
    }

    constexpr int NSTEPS = 3 + 10 * DEPTH;
#pragma unroll 1
    for (int step = 0; step < NSTEPS; ++step) {
#define FRESH_TID() ({ unsigned zv_; asm volatile("v_mov_b32 %0, 0" : "=v"(zv_)); wv_u * 64 + (int)__builtin_amdgcn_mbcnt_hi(~0u, __builtin_amdgcn_mbcnt_lo(~0u, zv_)); })
        const int tid = FRESH_TID();
        int bid = blockIdx.x; asm volatile("" : "+s"(bid));
        int G = G_u; asm volatile("" : "+s"(G));
        KP pp = (KP)__builtin_amdgcn_kernarg_segment_ptr(); asm volatile("" : "+s"(pp));
        unsigned char* ws = pp->ws;
        LAS unsigned char* lds = (LAS unsigned char*)lds_raw;
        float* mod = (float*)(ws + WS_MOD);
        bf16_t* Hb = (bf16_t*)(ws + WS_H); bf16_t* MIX = (bf16_t*)(ws + WS_MIX); bf16_t* U = (bf16_t*)(ws + WS_R1);
        bf16_t* Pb = (bf16_t*)(ws + WS_P); bf16_t* Qn = (bf16_t*)(ws + WS_QN); bf16_t* Kall = (bf16_t*)(ws + WS_KALL); bf16_t* Vall = (bf16_t*)(ws + WS_VALL);
        bf16_t* YTL = (bf16_t*)(ws + WS_YTL); bf16_t* YTC = (bf16_t*)(ws + WS_YTC); bf16_t* attO = (bf16_t*)(ws + WS_ATTO); bf16_t* fourO = (bf16_t*)(ws + WS_FOURO);
        bf16_t* XS = (bf16_t*)(ws + WS_XS); bf16_t* YPART = (bf16_t*)(ws + WS_YPART);
        const int kind = step < 3 ? step : 3 + (step - 3) % 10;
        const int L = step < 3 ? 0 : (step - 3) / 10;
        const bool lastL = (L == DEPTH - 1);
        const int mrows = lastL ? ML : MT;
        const float* modL = mod + (size_t)L * 9 * NMODC;
        if ((kind == ST_RM1 || kind == ST_RM2) && lastL) continue;
        int njobs = 0;
        if (kind == ST_P0) phase0(pp, lds, G, tid, bid);
        else if (kind == ST_P0B) phase0b(pp, G, tid, bid);
        else if (kind == ST_RM0 || kind == ST_RM1 || kind == ST_RM2) {
            RM a;
            a.row0 = 0; a.srcL = pp->in[0]; a.srcC = pp->in[2]; a.srcB = nullptr; a.dstF = nullptr; a.dstB = nullptr; a.y = nullptr; a.ysplit = nullptr; a.gate = nullptr; a.gpost = nullptr;
            if (kind == ST_RM0) { a.nrows = MT; a.H = Hb; a.gpre = pp->in[6]; a.shift = mod; a.scale = mod + DM; }
            else if (kind == ST_RM1) { a.row0 = ML; a.nrows = MT; a.dstB = XS; a.y = MIX; a.ysplit = YPART; a.gate = modL + 2 * DM; a.gpost = pp->in[7] + L * DM;
                a.H = MIX; a.gpre = pp->in[8] + L * DM; a.shift = modL + 3 * DM; a.scale = modL + 4 * DM; }
            else { a.row0 = ML; a.nrows = MT; a.srcB = XS; a.dstB = XS; a.y = MIX; a.ysplit = YPART; a.gate = modL + 5 * DM; a.gpost = pp->in[9] + L * DM;
                a.H = Hb; a.gpre = pp->in[6] + (L + 1) * DM; a.shift = modL + 9 * NMODC; a.scale = modL + 9 * NMODC + DM; }
            resid_mod(a, G, tid, bid);
        }
        else if (kind == ST_QK) { njobs = 1; }
        else if (kind == ST_MRG) merge_phase(attO, fourO, (const float*)(ws + WS_NYQ), pp->in[14] + L * 1024, pp->in[15] + L * 1024, Hb, mrows, G, tid, bid);
        else if (kind == ST_CGLU) glufix_phase(U, (const float*)(ws + WS_ZP), (const float*)(ws + WS_GV), (const float*)(ws + WS_VV), pp->in[18] + (size_t)L * 3 * FFN, mrows, G, tid, bid);
        else if (kind == ST_ATT) {
            const int nunits = lastL ? 512 : 576;
            for (int u = bid; u < nunits; u += G) {
                const att::bf16 *Qb, *Kh, *Vh; bf16_t* Ob; int seq;
                if (u < 512) {
                    int pair, j;
                    if (G == 256) { const int i = u >> 8, cc = u & 255; pair = i * 8 + (cc & 7); j = cc >> 3; } else { pair = u >> 5; j = u & 31; }
                    const int b = pair >> 1, kvh = pair & 1, gq = j >> 3, qb = j & 7, h = kvh * 4 + gq;
                    const size_t qrow = (size_t)b * SEQ + qb * 256;
                    Qb = (const att::bf16*)(Qn + qrow * 1024 + h * 128); Ob = attO + qrow * 1024 + h * 128;
                    Kh = (const att::bf16*)(Kall + (size_t)b * SKV * 256 + kvh * 128); Vh = (const att::bf16*)(Vall + (size_t)b * SKV * 256 + kvh * 128); seq = SKV;
                } else {
                    const int v = u - 512, b = v >> 3, h = v & 7;
                    const size_t qrow = (size_t)ML + b * CTXL;
                    Qb = (const att::bf16*)(Qn + qrow * 1024 + h * 128); Ob = attO + qrow * 1024 + h * 128;
                    Kh = (const att::bf16*)(Kall + ((size_t)b * SKV + SEQ) * 256 + (h >> 2) * 128); Vh = (const att::bf16*)(Vall + ((size_t)b * SKV + SEQ) * 256 + (h >> 2) * 128); seq = CTXL;
                }
                att::attn_dense_body(Qb, Kh, Vh, Ob, seq, (char*)lds_raw, tid);
                __syncthreads();
            }
            nyq_phase(YTL, (float*)(ws + WS_NYQ), G, tid, bid);
            njobs = lastL ? 1 : 2;
        }
        else njobs = ((kind == ST_G2 || kind == ST_G4) && !lastL) ? 2 : 1;

        if (kind == ST_G1) {
            const int ts = FRESH_TID();
            if (ts < 256) { const unsigned ti = (unsigned)ts & 127u; const float* qn_ = pp->in[11] + L * 128; const float* kn_ = pp->in[12] + L * 128;
                float nv; if (ts < 128) nv = qn_[ti]; else nv = kn_[ti];
                ((LAS float*)(lds + CWL_OFF))[ts] = nv; }
        }
        for (int j = 0; j < njobs; ++j) {
            const int tj = FRESH_TID();
            pg8::Job J; J.ksplit = 1; J.ostride_ks = 0; J.amod = 1 << 30; J.bdiv = 1 << 30; J.bstride_m = 0; J.mode = 0; J.scale = 1.f; J.O2 = nullptr; J.pp = pp; J.ws = ws; J.L = L; J.which = 0;
            if (kind == ST_G1) { J.A = Hb; J.lda = DM; J.B = (const bf16_t*)(ws + WS_WIN) + (size_t)L * INW * DM; J.ldb = DM; J.K = DM; J.nM = MT / 256; J.nN = INW / 256; J.O = Pb; J.ldc = INW; J.mode = 3; }
            else if (kind == ST_QK) { J.A = (const bf16_t*)(ws + WS_CWS) + (size_t)L * 8 * 256 * 128; J.lda = 128; J.B = Pb + QKVW; J.ldb = INW; J.K = 128; J.nM = 8; J.nN = mrows / 256;
                J.bdiv = 1; J.bstride_m = 128; J.O = YTL; J.O2 = YTC; J.ldc = 0; J.mode = 1; }
            else if (kind == ST_ATT) {
                if (j == 0) { J.A = (const bf16_t*)(ws + WS_D2048); J.lda = 2048; J.amod = 8; J.B = YTL; J.ldb = 2048; J.bdiv = 4; J.bstride_m = (long)1024 * 2048; J.K = 2048; J.nM = 64; J.nN = 4;
                    J.O = fourO; J.ldc = 1024; J.scale = 1.f / 512.f; }
                else { J.A = (const bf16_t*)(ws + WS_D256); J.lda = 512; J.amod = 1; J.B = YTC; J.ldb = 512; J.bdiv = 1; J.bstride_m = (long)1024 * 512; J.K = 512; J.nM = 8; J.nN = 4;
                    J.O = fourO + (size_t)ML * 1024; J.ldc = 1024; J.scale = 0.005524271728019903f; }
            }
            else if (kind == ST_G2) { J.A = Hb; J.lda = DM; J.B = (const bf16_t*)(ws + WS_WOUT) + (size_t)L * DM * DM; J.ldb = DM; J.K = DM; J.nM = ML / 256; J.nN = DM / 256; J.O = MIX; J.ldc = DM;
                if (j == 1) { J.A = Hb + (size_t)ML * DM; J.nM = MC / 256; J.ksplit = 4; J.K = DM / 4; J.O = YPART; J.ostride_ks = (long)MC * DM; }
                else { J.mode = 5; J.which = 0; } }
            else if (kind == ST_G3) { J.A = MIX; J.lda = DM; J.B = (const bf16_t*)(ws + WS_WUP) + (size_t)L * UPW * DM; J.ldb = DM; J.K = DM; J.nM = mrows / 256; J.nN = UPW / 256; J.O = U; J.ldc = FFN; J.mode = 2; }
            else { J.A = U; J.lda = FFN; J.B = (const bf16_t*)(ws + WS_WDN) + (size_t)L * DM * FFN; J.ldb = FFN; J.K = FFN; J.nM = ML / 256; J.nN = DM / 256; J.O = MIX; J.ldc = DM;
                if (j == 1) { J.A = U + (size_t)ML * FFN; J.nM = MC / 256; J.ksplit = 4; J.K = FFN / 4; J.O = YPART; J.ostride_ks = (long)MC * DM; }
                else { J.mode = lastL ? 4 : 5; J.which = 1; } }
            J.astride = (long)256 * J.lda; J.bstride_n = (long)256 * J.ldb;
            pg8::StaticOrder S; S.init(J.nM, J.nN * J.ksplit, G, bid); S.panel = (J.mode == 4 || J.mode == 5);
            __syncthreads();
            pg8::gemm_phase(lds, J, S, tj);
        }
        if (gridDim.y == 0x7fff) grid.sync();
        { XcdBarrier xb; xb.bar = (unsigned*)ws; xb.x = xb_xcc_id(); xb.st = (volatile LAS unsigned*)(lds + 131072); xcd_barrier(xb, FRESH_TID()); }
    }
}

extern "C" void kernel_launch(void* const* d_in, const int* in_sizes, int n_in, void* d_out, int out_size, void* d_ws, size_t ws_size, hipStream_t stream) {
    static int grid = 0;
    if (grid == 0) {
        if (n_in != 21 || out_size != ML * DM || ws_size < WS_END) { fprintf(stderr, "kernel_launch: unexpected shapes: n_in %d out %d ws %zu (need %zu)\n", n_in, out_size, ws_size, (size_t)WS_END); grid = -1; return; }
        int dev = 0, cus = 0, per_cu = 0;
        (void)hipGetDevice(&dev); (void)hipDeviceGetAttribute(&cus, hipDeviceAttributeMultiprocessorCount, dev);
        if (hipFuncSetAttribute((const void*)fwd_megakernel, hipFuncAttributeMaxDynamicSharedMemorySize, LDS_BYTES) != hipSuccess) { fprintf(stderr, "kernel_launch: hipFuncSetAttribute failed\n"); grid = -1; return; }
        if (hipOccupancyMaxActiveBlocksPerMultiprocessor(&per_cu, (const void*)fwd_megakernel, NTHREADS, LDS_BYTES) != hipSuccess || per_cu < 1) { fprintf(stderr, "kernel_launch: occupancy query gave %d\n", per_cu); (void)hipGetLastError(); per_cu = 1; }
        grid = cus;
        if (grid > cus * per_cu) grid = cus * per_cu;
    }
    if (grid < 0) return;
    if (hipMemsetAsync(d_ws, 0, 262144, stream) != hipSuccess) { fprintf(stderr, "kernel_launch: hipMemsetAsync failed\n"); return; }
    Params p{};
    for (int i = 0; i < 21; ++i) p.in[i] = (const float*)d_in[i];
    p.out = (float*)d_out; p.ws = (unsigned char*)d_ws;
    void* args[] = {&p};
    hipError_t e = hipLaunchCooperativeKernel((const void*)fwd_megakernel, dim3(grid), dim3(NTHREADS), args, LDS_BYTES, stream);
    if (e != hipSuccess) fprintf(stderr, "cooperative launch failed: %s (grid %d)\n", hipGetErrorString(e), grid);
}
```
